# Optimizing an MI355X kernel written in HIP

```python
import jax, jax.numpy as jnp
from jax import lax
import numpy as np

D_MODEL = 1024
BATCH = 16
SEQ = 2048
DEPTH = 1
DEC_BATCH = 16
DEC_SEQ = 64
PAST_LEN = 2048

CHUNK = 64
EPS = 1e-6
D_CONV_A = D_MODEL
CONV_A_WIDTH = 3
SSM_EXPAND = 2
D_INNER = SSM_EXPAND * D_MODEL
SSM_HEAD_DIM = 64
SSM_HEADS = D_INNER // SSM_HEAD_DIM
SSM_GROUPS = 8
HEADS_PER_GROUP = SSM_HEADS // SSM_GROUPS
SSM_STATE = 128
SSM_CONV_WIDTH = 4
SSM_CONV_DIM = D_INNER + 2 * SSM_GROUPS * SSM_STATE
D_FF = 4 * D_MODEL
N_BRANCHES = 2
OFF_A_B = 0
OFF_A_C = OFF_A_B + D_CONV_A
OFF_A_H = OFF_A_C + D_CONV_A
OFF_Z = OFF_A_H + D_CONV_A
OFF_XBC = OFF_Z + D_INNER
OFF_DT = OFF_XBC + SSM_CONV_DIM
OFF_GATE = OFF_DT + SSM_HEADS
PROJ_DIM = OFF_GATE + N_BRANCHES * D_MODEL

kernel_name = 'hybrid_shortconv_ssd_stream_step'

PARAM_NAMES = ('norm_mix_pre', 'w_in', 'b_gate', 'conv_a_w', 'w_a_out', 'conv_ssm_w', 'conv_ssm_b', 'dt_bias', 'a_log', 'd_skip', 'ssm_norm', 'w_ssm_out', 'w_o', 'norm_mix_post', 'norm_ffn_pre', 'w_ff1', 'w_ff2', 'norm_ffn_post')


def rms_norm(x, w):
    xf = x.astype(jnp.float32)
    xf = xf * lax.rsqrt(jnp.mean(xf * xf, axis=-1, keepdims=True) + EPS)
    return (xf * w.astype(jnp.float32)).astype(x.dtype)


def causal_dwconv(u, hist, w):
    k = w.shape[0]
    l = u.shape[1]
    full = jnp.concatenate([hist.astype(u.dtype), u], axis=1)
    out = full[:, 0:l] * w[0]
    for i in range(1, k):
        out = out + full[:, i:i + l] * w[i]
    return out, full[:, l:]


def segsum_exp(a):
    t = a.shape[-1]
    cs = jnp.cumsum(a, axis=-1)
    diff = cs[..., :, None] - cs[..., None, :]
    mask = jnp.tril(jnp.ones((t, t), dtype=bool))
    return jnp.where(mask, jnp.exp(jnp.where(mask, diff, 0.0)), 0.0)


def ssd_scan(x, dt, a, bm, cm, h0):
    b, l = x.shape[0], x.shape[1]
    cs = CHUNK if l % CHUNK == 0 else l
    nc = l // cs
    g, j, p, n = SSM_GROUPS, HEADS_PER_GROUP, SSM_HEAD_DIM, SSM_STATE
    xc = (x * dt[..., None]).reshape(b, nc, cs, g, j, p)
    adt = (dt * a).reshape(b, nc, cs, g, j)
    bc = bm.reshape(b, nc, cs, g, n)
    cc = cm.reshape(b, nc, cs, g, n)
    a_cum = jnp.cumsum(adt, axis=2)
    lmat = segsum_exp(jnp.moveaxis(adt, 2, -1))
    cb = jnp.einsum('bclgn,bcsgn->bcgls', cc, bc)
    y_diag = jnp.einsum('bcgjls,bcsgjp->bclgjp', cb[:, :, :, None] * lmat, xc)
    decay_in = jnp.exp(a_cum[:, :, -1:] - a_cum)
    chunk_states = jnp.einsum('bcsgn,bcsgj,bcsgjp->cbgjpn', bc, decay_in, xc)
    chunk_decay = jnp.moveaxis(jnp.exp(a_cum[:, :, -1]), 1, 0)

    def step(h, inp):
        s_c, d_c = inp
        return d_c[..., None, None] * h + s_c, h

    h_last, h_prev = lax.scan(step, h0.reshape(b, g, j, p, n), (chunk_states, chunk_decay))
    y_off = jnp.einsum('bclgn,cbgjpn,bclgj->bclgjp', cc, h_prev, jnp.exp(a_cum))
    y = (y_diag + y_off).reshape(b, l, SSM_HEADS, p)
    return y, h_last.reshape(b, SSM_HEADS, p, n)


def layer(x, conv_a_hist, conv_m_hist, ssm_h, prm):
    f32 = jnp.float32
    b, l = x.shape[0], x.shape[1]
    xn = rms_norm(x, prm['norm_mix_pre'])
    proj = xn @ prm['w_in']
    a_b = proj[..., OFF_A_B:OFF_A_C]
    a_c = proj[..., OFF_A_C:OFF_A_H]
    a_h = proj[..., OFF_A_H:OFF_Z]
    z = proj[..., OFF_Z:OFF_XBC]
    xbc = proj[..., OFF_XBC:OFF_DT]
    dt_raw = proj[..., OFF_DT:OFF_GATE]
    gates = jax.nn.sigmoid(proj[..., OFF_GATE:] + prm['b_gate'])
    conv_a, conv_a_new = causal_dwconv(a_c * a_h, conv_a_hist, prm['conv_a_w'])
    p_a = (a_b * conv_a) @ prm['w_a_out']
    xbc_c, conv_m_new = causal_dwconv(xbc, conv_m_hist, prm['conv_ssm_w'])
    xbc_c = jax.nn.silu(xbc_c + prm['conv_ssm_b'])
    xs = xbc_c[..., :D_INNER].reshape(b, l, SSM_HEADS, SSM_HEAD_DIM).astype(f32)
    gn = SSM_GROUPS * SSM_STATE
    bm = xbc_c[..., D_INNER:D_INNER + gn].reshape(b, l, SSM_GROUPS, SSM_STATE).astype(f32)
    cm = xbc_c[..., D_INNER + gn:].reshape(b, l, SSM_GROUPS, SSM_STATE).astype(f32)
    dt = jax.nn.softplus(dt_raw.astype(f32) + prm['dt_bias'].astype(f32))
    a = -jnp.exp(prm['a_log'].astype(f32))
    y, ssm_new = ssd_scan(xs, dt, a, bm, cm, ssm_h.astype(f32))
    y = y + prm['d_skip'].astype(f32)[:, None] * xs
    y = y.reshape(b, l, D_INNER) * jax.nn.silu(z.astype(f32))
    yg = y.reshape(b, l, SSM_GROUPS, D_INNER // SSM_GROUPS)
    yg = yg * lax.rsqrt(jnp.mean(yg * yg, axis=-1, keepdims=True) + EPS)
    y = (yg.reshape(b, l, D_INNER) * prm['ssm_norm'].astype(f32)).astype(x.dtype)
    p_b = y @ prm['w_ssm_out']
    merged = gates[..., :D_MODEL] * p_a + gates[..., D_MODEL:] * p_b
    h = x + rms_norm(merged @ prm['w_o'], prm['norm_mix_post'])
    f = rms_norm(h, prm['norm_ffn_pre']) @ prm['w_ff1']
    f = jnp.square(jax.nn.relu(f)) @ prm['w_ff2']
    out = h + rms_norm(f, prm['norm_ffn_post'])
    return out, conv_a_new, conv_m_new, ssm_new.astype(ssm_h.dtype)


def setup_inputs(seed: int = 0) -> dict:
    key = jax.random.key(seed)
    ks = jax.random.split(key, 32)
    nrm = jax.random.normal
    f32 = jnp.float32
    dt0 = jnp.exp(jax.random.uniform(ks[10], (DEPTH, SSM_HEADS), f32, np.log(1e-3), np.log(1e-1)))
    return {
        'x_prompt': nrm(ks[0], (BATCH, SEQ, D_MODEL), f32),
        'x_sample': nrm(ks[1], (DEC_BATCH, DEC_SEQ, D_MODEL), f32),
        'state_conv_a': nrm(ks[2], (DEPTH, DEC_BATCH, CONV_A_WIDTH - 1, D_CONV_A), f32),
        'state_conv_ssm': nrm(ks[3], (DEPTH, DEC_BATCH, SSM_CONV_WIDTH - 1, SSM_CONV_DIM), f32),
        'state_ssm': 0.1 * nrm(ks[4], (DEPTH, DEC_BATCH, SSM_HEADS, SSM_HEAD_DIM, SSM_STATE), f32),
        'norm_mix_pre': 1.0 + 0.02 * nrm(ks[5], (DEPTH, D_MODEL), f32),
        'w_in': nrm(ks[6], (DEPTH, D_MODEL, PROJ_DIM), f32) * D_MODEL ** -0.5,
        'b_gate': 0.01 * nrm(ks[7], (DEPTH, N_BRANCHES * D_MODEL), f32),
        'conv_a_w': nrm(ks[8], (DEPTH, CONV_A_WIDTH, D_CONV_A), f32) * CONV_A_WIDTH ** -0.5,
        'w_a_out': nrm(ks[9], (DEPTH, D_CONV_A, D_MODEL), f32) * D_CONV_A ** -0.5,
        'conv_ssm_w': nrm(ks[11], (DEPTH, SSM_CONV_WIDTH, SSM_CONV_DIM), f32) * SSM_CONV_WIDTH ** -0.5,
        'conv_ssm_b': 0.01 * nrm(ks[12], (DEPTH, SSM_CONV_DIM), f32),
        'dt_bias': dt0 + jnp.log(-jnp.expm1(-dt0)),
        'a_log': jnp.log(jax.random.uniform(ks[13], (DEPTH, SSM_HEADS), f32, 1.0, 16.0)),
        'd_skip': 1.0 + 0.02 * nrm(ks[14], (DEPTH, SSM_HEADS), f32),
        'ssm_norm': 1.0 + 0.02 * nrm(ks[15], (DEPTH, D_INNER), f32),
        'w_ssm_out': nrm(ks[16], (DEPTH, D_INNER, D_MODEL), f32) * D_INNER ** -0.5,
        'w_o': nrm(ks[17], (DEPTH, D_MODEL, D_MODEL), f32) * D_MODEL ** -0.5,
        'norm_mix_post': 1.0 + 0.02 * nrm(ks[18], (DEPTH, D_MODEL), f32),
        'norm_ffn_pre': 1.0 + 0.02 * nrm(ks[19], (DEPTH, D_MODEL), f32),
        'w_ff1': nrm(ks[20], (DEPTH, D_MODEL, D_FF), f32) * D_MODEL ** -0.5,
        'w_ff2': nrm(ks[21], (DEPTH, D_FF, D_MODEL), f32) * D_FF ** -0.5,
        'norm_ffn_post': 1.0 + 0.02 * nrm(ks[22], (DEPTH, D_MODEL), f32),
    }


def reference(x_prompt, x_sample, state_conv_a, state_conv_ssm, state_ssm, norm_mix_pre, w_in, b_gate, conv_a_w, w_a_out, conv_ssm_w, conv_ssm_b, dt_bias, a_log, d_skip, ssm_norm, w_ssm_out, w_o, norm_mix_post, norm_ffn_pre, w_ff1, w_ff2, norm_ffn_post):
    weights = (norm_mix_pre, w_in, b_gate, conv_a_w, w_a_out, conv_ssm_w, conv_ssm_b, dt_bias, a_log, d_skip, ssm_norm, w_ssm_out, w_o, norm_mix_post, norm_ffn_pre, w_ff1, w_ff2, norm_ffn_post)
    bp = x_prompt.shape[0]
    dtp = x_prompt.dtype
    yp, ys = x_prompt, x_sample
    pa, pm, ps, sa, sm, ss = [], [], [], [], [], []
    for i in range(DEPTH):
        prm = {name: arr[i] for name, arr in zip(PARAM_NAMES, weights)}
        zero_a = jnp.zeros((bp, CONV_A_WIDTH - 1, D_CONV_A), dtp)
        zero_m = jnp.zeros((bp, SSM_CONV_WIDTH - 1, SSM_CONV_DIM), dtp)
        zero_s = jnp.zeros((bp, SSM_HEADS, SSM_HEAD_DIM, SSM_STATE), state_ssm.dtype)
        yp, ca_p, cm_p, s_p = layer(yp, zero_a, zero_m, zero_s, prm)
        ys, ca_s, cm_s, s_s = layer(ys, state_conv_a[i], state_conv_ssm[i], state_ssm[i], prm)
        pa.append(ca_p); pm.append(cm_p); ps.append(s_p)
        sa.append(ca_s); sm.append(cm_s); ss.append(s_s)
    return (yp, ys, jnp.stack(pa), jnp.stack(pm), jnp.stack(ps), jnp.stack(sa), jnp.stack(sm), jnp.stack(ss))
```

```cpp
#include <hip/hip_runtime.h>
#include <hip/hip_cooperative_groups.h>
#include <cstdio>
#include <cstdint>
namespace cg = cooperative_groups;
namespace pg8 {
#define PG8_LAS __attribute__((address_space(3)))
typedef unsigned short bf16_t;
typedef short bf16x8 __attribute__((ext_vector_type(8)));
typedef float f32x4 __attribute__((ext_vector_type(4)));
typedef unsigned u32x4 __attribute__((ext_vector_type(4)));
constexpr int BM = 256, BK = 64, HALF = 128, HTB = HALF * BK * 2  , STAGE_BYTES = 8 * HTB, NXCD = 8, WGM = 8;

__host__ __device__ __forceinline__ int lds_byte(int r, int c) { const int st = (r >> 4) * 2 + (c >> 5), rr = r & 15, cc = c & 31, ob = rr * 64 + cc * 2; return st * 1024 + (ob ^ (((ob >> 9) & 1) << 5)); }
__host__ __device__ __forceinline__ void stage_rc(int b, int& R, int& C) { const int st = b / 1024, sb = b % 1024, swz = sb ^ (((sb >> 9) & 1) << 5); R = (st >> 1) * 16 + swz / 64; C = (st & 1) * 32 + (swz % 64) / 2; }
__host__ __device__ __forceinline__ int perm32(int rho) { const int n = rho >> 4, i = rho & 15; return 8 * (i >> 2) + 4 * n + (i & 3); }

struct Unit { int pm, pn, kb; };
struct Gemm { const bf16_t* A; const bf16_t* Bt; int M, N, K, KL; };

struct StaticOrder {
    int nM, nN, nwg, G, c;
    __host__ __device__ void init(int M, int N, int G_, int c_) { nM = M / BM; nN = N / BM; nwg = nM * nN; G = G_; c = c_; }
    __host__ __device__ bool next(int i, Unit& u) const {
        const long L = (long)i * G + c; if (L >= nwg || c < 0) return false;
        int wgid = (int)L; { const int q = nwg / NXCD, r = nwg % NXCD, xcd = wgid % NXCD, off = wgid / NXCD; wgid = (xcd < r ? xcd * (q + 1) : r * (q + 1) + (xcd - r) * q) + off; }
        const int nig = WGM * nN, gid = wgid / nig, fm = gid * WGM, gsz = (nM - fm) < WGM ? (nM - fm) : WGM;
        u.pm = fm + ((wgid % nig) % gsz); u.pn = (wgid % nig) / gsz; u.kb = 0; return true;
    }
    __device__ __forceinline__ void a_ready(const Unit&) const {}
    __device__ __forceinline__ void done(const Unit&) const {}
};

__device__ __forceinline__ unsigned cvt_pk_bf16(float lo, float hi) { unsigned r; asm volatile("v_cvt_pk_bf16_f32 %0, %1, %2" : "=v"(r) : "v"(lo), "v"(hi)); return r; }
__device__ __forceinline__ u32x4 pack8(f32x4 v0, f32x4 v1) { u32x4 w; w.x = cvt_pk_bf16(v0[0], v0[1]); w.y = cvt_pk_bf16(v0[2], v0[3]); w.z = cvt_pk_bf16(v1[0], v1[1]); w.w = cvt_pk_bf16(v1[2], v1[3]); return w; }
__device__ __forceinline__ float bf_lo(unsigned w) { return __uint_as_float(w << 16); }
__device__ __forceinline__ float bf_hi(unsigned w) { return __uint_as_float(w & 0xffff0000u); }
__device__ __forceinline__ void unpack8(u32x4 w, f32x4& v0, f32x4& v1) { v0 = (f32x4){bf_lo(w.x), bf_hi(w.x), bf_lo(w.y), bf_hi(w.y)}; v1 = (f32x4){bf_lo(w.z), bf_hi(w.z), bf_lo(w.w), bf_hi(w.w)}; }
__device__ __forceinline__ float sigm(float v) { return 1.0f / (1.0f + __expf(-v)); }

#define EPI_LOOP_AM _Pragma("unroll") for (int ai = 0; ai < 2; ++ai) _Pragma("unroll") for (int m = 0; m < 4; ++m)

struct EpiP1a {
    static constexpr bool PERM = true, AFTER_DRAIN = false;
    bf16_t* Z; bf16_t* XBC; float* DT;
    __device__ __forceinline__ void operator()(const f32x4 (&acc)[2][2][4][2], const Unit& u, int wr, int wc, int fr, int fq) const {
        const int row0 = u.pm * BM + wr * 64 + fr, col0 = wc * 32 + 8 * fq;
        if (u.pn < 24) {
            bf16_t* base; int ldc;
            if (u.pn < 8) { base = Z + u.pn * 256; ldc = 2048; } else { base = XBC + (u.pn - 8) * 256; ldc = 4096; }
            EPI_LOOP_AM { bf16_t* rowp = base + (size_t)(row0 + ai * HALF + m * 16) * ldc + col0;
#pragma unroll
                for (int bj = 0; bj < 2; ++bj) *(u32x4*)(rowp + bj * HALF) = pack8(acc[ai][bj][m][0], acc[ai][bj][m][1]); }
        } else if (wc == 0) {
            EPI_LOOP_AM { float* rowp = DT + (size_t)(row0 + ai * HALF + m * 16) * 32 + 8 * fq; *(f32x4*)rowp = acc[ai][0][m][0]; *(f32x4*)(rowp + 4) = acc[ai][0][m][1]; }
        }
    }
};
__device__ __forceinline__ void epi_gate_store(const f32x4 (&acc)[2][2][4][2], bf16_t* GT, const float* bias, int pt, int row0, int col0) {
    const int gc = pt * 256 + col0; bf16_t* base = GT + gc;
    f32x4 bv[2][2];
#pragma unroll
    for (int bj = 0; bj < 2; ++bj)
#pragma unroll
        for (int n = 0; n < 2; ++n) bv[bj][n] = *(const f32x4*)(bias + gc + bj * HALF + 4 * n);
    EPI_LOOP_AM { bf16_t* rowp = base + (size_t)(row0 + ai * HALF + m * 16) * 1024;
#pragma unroll
        for (int bj = 0; bj < 2; ++bj) { f32x4 v0 = acc[ai][bj][m][0] + bv[bj][0], v1 = acc[ai][bj][m][1] + bv[bj][1];
#pragma unroll
            for (int e = 0; e < 4; ++e) { v0[e] = sigm(v0[e]); v1[e] = sigm(v1[e]); }
            *(u32x4*)(rowp + bj * HALF) = pack8(v0, v1); } }
}
struct EpiP2g {
    static constexpr bool PERM = true, AFTER_DRAIN = false;
    bf16_t* AB; bf16_t* GA; const float* bgate;
    __device__ __forceinline__ void operator()(const f32x4 (&acc)[2][2][4][2], const Unit& u, int wr, int wc, int fr, int fq) const {
        const int row0 = u.pm * BM + wr * 64 + fr, col0 = wc * 32 + 8 * fq;
        if (u.pn < 4) {
            bf16_t* base = AB + u.pn * 256;
            EPI_LOOP_AM { bf16_t* rowp = base + (size_t)(row0 + ai * HALF + m * 16) * 1024 + col0;
#pragma unroll
                for (int bj = 0; bj < 2; ++bj) *(u32x4*)(rowp + bj * HALF) = pack8(acc[ai][bj][m][0], acc[ai][bj][m][1]); }
        } else epi_gate_store(acc, GA, bgate, u.pn - 4, row0, col0);
    }
};
struct EpiP1b {
    static constexpr bool PERM = true, AFTER_DRAIN = false;
    bf16_t* V; bf16_t* GB; const float* bgate; int pmo;
    __device__ __forceinline__ void operator()(const f32x4 (&acc)[2][2][4][2], const Unit& u, int wr, int wc, int fr, int fq) const {
        const int row0 = (u.pm + pmo) * BM + wr * 64 + fr, col0 = wc * 32 + 8 * fq;
        if (u.pn < 8) {
            bf16_t* base = V + u.pn * 128;
            EPI_LOOP_AM { bf16_t* rowp = base + (size_t)(row0 + ai * HALF + m * 16) * 1024 + col0;
                *(u32x4*)rowp = pack8(acc[ai][0][m][0] * acc[ai][1][m][0], acc[ai][0][m][1] * acc[ai][1][m][1]); }
        } else epi_gate_store(acc, GB, bgate + 1024, u.pn - 8, row0, col0);
    }
};
template <int MODE> struct EpiGate {
    static constexpr bool PERM = true, AFTER_DRAIN = false;
    bf16_t* O; const bf16_t* Gp; const bf16_t* Gs;
    __device__ __forceinline__ void operator()(const f32x4 (&acc)[2][2][4][2], const Unit& u, int wr, int wc, int fr, int fq) const {
        const int row0 = u.pm * BM + wr * 64 + fr, col0 = u.pn * BM + wc * 32 + 8 * fq;
        const bf16_t* G = u.pm < 128 ? Gp : Gs;
#pragma unroll
        for (int ai = 0; ai < 2; ++ai) {
            u32x4 gq[4][2], oq[4][2];
#pragma unroll
            for (int m = 0; m < 4; ++m)
#pragma unroll
                for (int bj = 0; bj < 2; ++bj) { const size_t off = (size_t)(row0 + ai * HALF + m * 16) * 1024 + col0 + bj * HALF;
                    gq[m][bj] = *(const u32x4*)(G + off); if (MODE == 1) oq[m][bj] = *(const u32x4*)(O + off); }
#pragma unroll
            for (int m = 0; m < 4; ++m)
#pragma unroll
                for (int bj = 0; bj < 2; ++bj) { const size_t off = (size_t)(row0 + ai * HALF + m * 16) * 1024 + col0 + bj * HALF;
                    f32x4 g0, g1; unpack8(gq[m][bj], g0, g1);
                    f32x4 v0 = g0 * acc[ai][bj][m][0], v1 = g1 * acc[ai][bj][m][1];
                    if (MODE == 1) { f32x4 o0, o1; unpack8(oq[m][bj], o0, o1); v0 += o0; v1 += o1; }
                    *(u32x4*)(O + off) = pack8(v0, v1); }
        }
    }
};
struct EpiSsq {
    static constexpr bool PERM = true, AFTER_DRAIN = false;
    bf16_t* O; float* SSQ;
    __device__ __forceinline__ void operator()(const f32x4 (&acc)[2][2][4][2], const Unit& u, int wr, int wc, int fr, int fq) const {
        const int row0 = u.pm * BM + wr * 64 + fr, col0 = u.pn * BM + wc * 32 + 8 * fq;
        EPI_LOOP_AM { const size_t row = (size_t)(row0 + ai * HALF + m * 16); float s = 0.f;
#pragma unroll
            for (int bj = 0; bj < 2; ++bj) { const f32x4 v0 = acc[ai][bj][m][0], v1 = acc[ai][bj][m][1];
                s += (v0[0] * v0[0] + v0[1] * v0[1]) + (v0[2] * v0[2] + v0[3] * v0[3]) + (v1[0] * v1[0] + v1[1] * v1[1]) + (v1[2] * v1[2] + v1[3] * v1[3]);
                *(u32x4*)(O + row * 1024 + col0 + bj * HALF) = pack8(v0, v1); }
            s += __shfl_xor(s, 16); s += __shfl_xor(s, 32);
            if (fq == 0) atomicAdd(SSQ + row, s); }
    }
};
struct TailOrder {
    int G, c, NS, kbytes;
    __host__ __device__ bool next(int i, Unit& u) const {
        const int L = i * G + c; if (L >= 16 * NS) return false;
        const int un = L / NS, ks = L % NS; u.pm = 128 + (un >> 2); u.pn = un & 3; u.kb = ks * kbytes; return true;
    }
    __device__ __forceinline__ void a_ready(const Unit&) const {}
    __device__ __forceinline__ void done(const Unit&) const {}
};
struct EpiPartial {
    static constexpr bool PERM = false, AFTER_DRAIN = false;
    float* SCR; int kbytes;
    __device__ __forceinline__ void operator()(const f32x4 (&acc)[2][2][4][2], const Unit& u, int wr, int wc, int fr, int fq) const {
        const int row0 = (u.pm - 128) * BM + wr * 64 + fr, col0 = u.pn * BM + wc * 32 + 4 * fq;
        float* base = SCR + (size_t)(u.kb / kbytes) * 1024 * 1024;
        EPI_LOOP_AM { float* rowp = base + (size_t)(row0 + ai * HALF + m * 16) * 1024 + col0;
#pragma unroll
            for (int bj = 0; bj < 2; ++bj)
#pragma unroll
                for (int n = 0; n < 2; ++n) *(f32x4*)(rowp + bj * HALF + n * 16) = acc[ai][bj][m][n]; }
    }
};
struct EpiRelu2 {
    static constexpr bool PERM = true, AFTER_DRAIN = false;
    bf16_t* O; const float* RS;
    __device__ __forceinline__ void operator()(const f32x4 (&acc)[2][2][4][2], const Unit& u, int wr, int wc, int fr, int fq) const {
        const int row0 = u.pm * BM + wr * 64 + fr, col0 = u.pn * BM + wc * 32 + 8 * fq;
        float rsv[2][4];
#pragma unroll
        for (int ai = 0; ai < 2; ++ai)
#pragma unroll
            for (int m = 0; m < 4; ++m) rsv[ai][m] = RS[row0 + ai * HALF + m * 16];
        EPI_LOOP_AM { bf16_t* rowp = O + (size_t)(row0 + ai * HALF + m * 16) * 4096 + col0; const float rs = rsv[ai][m];
#pragma unroll
            for (int bj = 0; bj < 2; ++bj) { f32x4 v0 = acc[ai][bj][m][0], v1 = acc[ai][bj][m][1];
#pragma unroll
                for (int e = 0; e < 4; ++e) { const float a = fmaxf(v0[e], 0.f) * rs, b = fmaxf(v1[e], 0.f) * rs; v0[e] = a * a; v1[e] = b * b; }
                *(u32x4*)(rowp + bj * HALF) = pack8(v0, v1); } }
    }
};

template <class Epi, class Sched, bool ALIGN_EPI = false, bool SP2 = false>
__device__ __forceinline__ void gemm_phase(PG8_LAS unsigned char* lds, const Gemm g, const Sched& S, const Epi& E) {
    int tid = threadIdx.x; asm volatile("" : "+v"(tid));
    const int wid = __builtin_amdgcn_readfirstlane(tid >> 6), lane = tid & 63, wr = wid >> 2, wc = wid & 3, fr = lane & 15, fq = lane >> 4;
    const int K = g.K, nt = g.KL / BK;
    unsigned voffA[2], voffB[2];
#pragma unroll
    for (int i = 0; i < 2; ++i) { int R, C; stage_rc(tid * 16 + i * 8192, R, C); const int Rb = Epi::PERM ? ((R & ~31) + perm32(R & 31)) : R;
        voffA[i] = (unsigned)(R * K + C) * 2u; voffB[i] = (unsigned)(Rb * K + C) * 2u; }
    const size_t kstep = (size_t)(BK * 2);
    const size_t hstep = (size_t)HALF * K * 2;
    const size_t tstep = 2 * hstep;
    const unsigned ldsw = (unsigned)wid * 1024u;
    const int aoff = lds_byte(wr * 64 + fr, fq * 8), boff = lds_byte(wc * 32 + fr, fq * 8);
#define PG8_SA(b, h) (((b) * 2 + (h)) * HTB)
#define PG8_SB(b, h) ((4 + (b) * 2 + (h)) * HTB)
#define PG8_STAGE(bufoff, gbase, voff) do { _Pragma("unroll") for (int _i = 0; _i < 2; ++_i) \
        __builtin_amdgcn_global_load_lds((const unsigned*)((const char*)(gbase) + (voff)[_i]), (PG8_LAS unsigned*)(lds + (bufoff) + ldsw + _i * 8192), 16, 0, 0); } while (0)
#define PG8_LDA(dst, b, h) do { _Pragma("unroll") for (int m = 0; m < 4; ++m) _Pragma("unroll") for (int k = 0; k < 2; ++k) dst[m][k] = *(const PG8_LAS bf16x8*)(lds + PG8_SA(b, h) + aoff + m * 2048 + k * 1024); } while (0)
#define PG8_LDB(dst, b, h) do { _Pragma("unroll") for (int n = 0; n < 2; ++n) _Pragma("unroll") for (int k = 0; k < 2; ++k) dst[n][k] = *(const PG8_LAS bf16x8*)(lds + PG8_SB(b, h) + boff + n * 2048 + k * 1024); } while (0)
#define PG8_MMA(ai, bj, At, Bt) do { __builtin_amdgcn_s_setprio(1); _Pragma("unroll") for (int m = 0; m < 4; ++m) _Pragma("unroll") for (int n = 0; n < 2; ++n) _Pragma("unroll") for (int k = 0; k < 2; ++k) \
        acc[ai][bj][m][n] = __builtin_amdgcn_mfma_f32_16x16x32_bf16(Bt[n][k], At[m][k], acc[ai][bj][m][n], 0, 0, 0); __builtin_amdgcn_s_setprio(0); } while (0)
#define PG8_WAIT_V(n) asm volatile("s_waitcnt vmcnt(" #n ")" ::: "memory")
#define PG8_WAIT_L(n) asm volatile("s_waitcnt lgkmcnt(" #n ")" ::: "memory")
#define PG8_BAR __builtin_amdgcn_s_barrier()
#define PG8_SCHED __builtin_amdgcn_sched_barrier(0)
    Unit cur, nxt; int ui = 0;
    if (!S.next(0, cur)) return;
    f32x4 acc[2][2][4][2];
#pragma unroll
    for (int a = 0; a < 2; ++a)
#pragma unroll
        for (int b = 0; b < 2; ++b)
#pragma unroll
            for (int m = 0; m < 4; ++m)
#pragma unroll
                for (int n = 0; n < 2; ++n) acc[a][b][m][n] = (f32x4){0.f, 0.f, 0.f, 0.f};
    bf16x8 At[4][2], B0[2][2], B1[2][2];
    const char* cA = (const char*)g.A + (size_t)cur.pm * tstep + cur.kb; const char* cB = (const char*)g.Bt + (size_t)cur.pn * tstep + cur.kb;
    S.a_ready(cur);
    if constexpr (SP2) {
        PG8_STAGE(PG8_SB(0, 0), cB, voffB); PG8_STAGE(PG8_SB(0, 1), cB + hstep, voffB); PG8_STAGE(PG8_SA(0, 0), cA, voffA); PG8_STAGE(PG8_SA(0, 1), cA + hstep, voffA);
        if (wr == 1) PG8_BAR;
        PG8_WAIT_V(2); PG8_BAR;
        PG8_STAGE(PG8_SB(1, 0), cB + kstep, voffB); PG8_STAGE(PG8_SA(1, 0), cA + kstep, voffA); PG8_STAGE(PG8_SB(1, 1), cB + hstep + kstep, voffB);
        PG8_WAIT_V(6); PG8_BAR;
    } else {
        PG8_STAGE(PG8_SB(0, 0), cB, voffB); PG8_STAGE(PG8_SA(0, 0), cA, voffA); PG8_STAGE(PG8_SB(0, 1), cB + hstep, voffB); PG8_STAGE(PG8_SA(0, 1), cA + hstep, voffA);
        if (wr == 1) PG8_BAR;
        PG8_WAIT_V(4); PG8_BAR;
        PG8_STAGE(PG8_SB(1, 0), cB + kstep, voffB); PG8_STAGE(PG8_SA(1, 0), cA + kstep, voffA); PG8_STAGE(PG8_SB(1, 1), cB + hstep + kstep, voffB);
        PG8_WAIT_V(6); PG8_BAR;
    }
    for (;;) {
        const bool has_next = S.next(ui + 1, nxt);
        const char* nA = has_next ? (const char*)g.A + (size_t)nxt.pm * tstep + nxt.kb : cA; const char* nB = has_next ? (const char*)g.Bt + (size_t)nxt.pn * tstep + nxt.kb : cB;
        for (int t = 0; t < nt; t += 2) {
            const bool last = (t == nt - 2);
            const char* a1 = cA + (size_t)(t + 1) * kstep;
            const char* a2 = last ? nA : cA + (size_t)(t + 2) * kstep; const char* b2 = last ? nB : cB + (size_t)(t + 2) * kstep;
            const char* a3 = a2 + kstep; const char* b3 = b2 + kstep;
            if (last && has_next) S.a_ready(nxt);
            if constexpr (SP2) {
            PG8_LDB(B0, 0, 0); PG8_LDB(B1, 0, 1); PG8_SCHED; PG8_LDA(At, 0, 0); PG8_STAGE(PG8_SA(1, 1), a1 + hstep, voffA);
            PG8_WAIT_V(8); PG8_WAIT_L(0); PG8_BAR; PG8_MMA(0, 0, At, B0); PG8_MMA(0, 1, At, B1); PG8_BAR; PG8_SCHED;
            PG8_LDA(At, 0, 1); PG8_STAGE(PG8_SB(0, 0), b2, voffB); PG8_STAGE(PG8_SB(0, 1), b2 + hstep, voffB); PG8_STAGE(PG8_SA(0, 0), a2, voffA);
            PG8_WAIT_V(8); PG8_WAIT_L(0); PG8_BAR; PG8_MMA(1, 0, At, B0); PG8_MMA(1, 1, At, B1); PG8_BAR; PG8_SCHED;
            PG8_LDB(B0, 1, 0); PG8_LDB(B1, 1, 1); PG8_SCHED; PG8_LDA(At, 1, 0); PG8_STAGE(PG8_SA(0, 1), a2 + hstep, voffA);
            PG8_WAIT_V(8); PG8_WAIT_L(0); PG8_BAR; PG8_MMA(0, 0, At, B0); PG8_MMA(0, 1, At, B1); PG8_BAR; PG8_SCHED;
            PG8_LDA(At, 1, 1); PG8_STAGE(PG8_SB(1, 0), b3, voffB); PG8_STAGE(PG8_SB(1, 1), b3 + hstep, voffB); PG8_STAGE(PG8_SA(1, 0), a3, voffA);
            PG8_WAIT_V(8); PG8_WAIT_L(0); PG8_BAR; PG8_MMA(1, 0, At, B0); PG8_MMA(1, 1, At, B1); PG8_BAR; PG8_SCHED;
            } else {
            PG8_LDB(B0, 0, 0); PG8_SCHED; PG8_LDA(At, 0, 0); PG8_STAGE(PG8_SA(1, 1), a1 + hstep, voffA);
            PG8_WAIT_L(8); PG8_BAR; PG8_WAIT_L(0); PG8_MMA(0, 0, At, B0); PG8_BAR; PG8_SCHED;
            PG8_LDB(B1, 0, 1); PG8_STAGE(PG8_SB(0, 0), b2, voffB);
            PG8_BAR; PG8_WAIT_L(0); PG8_MMA(0, 1, At, B1); PG8_BAR;
            PG8_LDA(At, 0, 1); PG8_STAGE(PG8_SA(0, 0), a2, voffA);
            PG8_BAR; PG8_WAIT_L(0); PG8_MMA(1, 0, At, B0); PG8_BAR; PG8_SCHED;
            PG8_STAGE(PG8_SB(0, 1), b2 + hstep, voffB);
            PG8_WAIT_V(6); PG8_BAR; PG8_MMA(1, 1, At, B1); PG8_BAR;
            PG8_LDB(B0, 1, 0); PG8_SCHED; PG8_LDA(At, 1, 0); PG8_STAGE(PG8_SA(0, 1), a2 + hstep, voffA);
            PG8_WAIT_L(8); PG8_BAR; PG8_WAIT_L(0); PG8_MMA(0, 0, At, B0); PG8_BAR; PG8_SCHED;
            PG8_LDB(B1, 1, 1); PG8_STAGE(PG8_SB(1, 0), b3, voffB);
            PG8_BAR; PG8_WAIT_L(0); PG8_MMA(0, 1, At, B1); PG8_BAR;
            PG8_LDA(At, 1, 1); PG8_STAGE(PG8_SA(1, 0), a3, voffA);
            PG8_BAR; PG8_WAIT_L(0); PG8_MMA(1, 0, At, B0); PG8_BAR; PG8_SCHED;
            PG8_STAGE(PG8_SB(1, 1), b3 + hstep, voffB);
            PG8_WAIT_V(6); PG8_BAR; PG8_MMA(1, 1, At, B1); PG8_BAR;
            }
        }
        if constexpr (ALIGN_EPI) { if (wr == 0) PG8_BAR; }
        if constexpr (!Epi::AFTER_DRAIN) { E(acc, cur, wr, wc, fr, fq); S.done(cur); }
        if (!has_next) break;
#pragma unroll
        for (int a = 0; a < 2; ++a)
#pragma unroll
            for (int b = 0; b < 2; ++b)
#pragma unroll
                for (int m = 0; m < 4; ++m)
#pragma unroll
                    for (int n = 0; n < 2; ++n) acc[a][b][m][n] = (f32x4){0.f, 0.f, 0.f, 0.f};
        cur = nxt; cA = nA; cB = nB; ++ui;
        if constexpr (ALIGN_EPI) { if (wr == 1) PG8_BAR; }
    }
    PG8_WAIT_V(0);
    if constexpr (!ALIGN_EPI) { if (wr == 0) PG8_BAR; }
    PG8_BAR;
    if constexpr (Epi::AFTER_DRAIN) { E.fused(acc, cur, wr, wc, fr, fq, lds, wid, lane); S.done(cur); }
#undef PG8_SA
#undef PG8_SB
#undef PG8_STAGE
#undef PG8_LDA
#undef PG8_LDB
#undef PG8_MMA
#undef PG8_WAIT_V
#undef PG8_WAIT_L
#undef PG8_BAR
#undef PG8_SCHED
}
}

#define LAS __attribute__((address_space(3)))
typedef unsigned short bf16;
typedef float f32x4 __attribute__((ext_vector_type(4)));
typedef short bf16x8 __attribute__((ext_vector_type(8)));
typedef short s16x4 __attribute__((ext_vector_type(4)));
typedef unsigned u32x4 __attribute__((ext_vector_type(4)));
typedef unsigned u32x2 __attribute__((ext_vector_type(2)));
constexpr int NWAVES = 8;
constexpr int DM = 1024, M_P = 16 * 2048, M_S = 16 * 64, M = M_P + M_S;
constexpr int PROJ = 11296, DI = 2048, NH = 32, NG = 8, DS = 128, CD = 4096, FF = 4096;
constexpr int N1A = 6400, N1B = 5120, NWIN = N1A + N1B;
constexpr float EPS = 1e-6f;
constexpr size_t O_Y = 0, O_CA_P = (size_t)M * DM, O_CM_P = O_CA_P + 16 * 2 * 1024, O_SS_P = O_CM_P + 16 * 3 * 4096, O_CA_S = O_SS_P + (size_t)16 * 32 * 64 * 128,
                 O_CM_S = O_CA_S + 16 * 2 * 1024, O_SS_S = O_CM_S + 16 * 3 * 4096;
constexpr size_t MiB = 1u << 20;
constexpr size_t WS_SSQ1 = 0, WS_SSQ2 = 256 * 1024, WS_BAR = 512 * 1024, WS_RX = 576 * 1024  , WS_RH = 768 * 1024  ;
constexpr size_t WS_WA = 1 * MiB;
constexpr size_t WS_WB = WS_WA + 2 * MiB;
constexpr size_t WS_WO = WS_WB + 4 * MiB;
constexpr size_t WS_W1 = WS_WO + 2 * MiB;
constexpr size_t WS_W2 = WS_W1 + 8 * MiB;
constexpr size_t WS_WINB = 25 * MiB;
constexpr size_t WS_XN = 35 * MiB;
constexpr size_t WS_DT = 101 * MiB;
constexpr size_t WS_XBC = 106 * MiB;
constexpr size_t WS_AB = 370 * MiB, WS_GA = 436 * MiB;
constexpr size_t WS_WINA = 512 * MiB - (size_t)N1A * 1024 * 2;
constexpr size_t WS_V = WS_XBC, WS_GB = WS_V + 66 * MiB, WS_MG = WS_GB + 66 * MiB, WS_MO = WS_MG + 66 * MiB;
constexpr size_t WS_F = WS_XBC, WS_F2 = WS_AB;
constexpr size_t WS_SCR = 436 * MiB;
constexpr size_t WS_VS = 502 * MiB, WS_GBS = 504 * MiB;
constexpr size_t WS_END = 512 * MiB;
static_assert(WS_W2 + 8 * MiB <= WS_WINB && WS_WINB + (size_t)N1B * 1024 * 2 <= WS_XN && WS_XN + (size_t)M * 1024 * 2 <= WS_DT && WS_DT + (size_t)M * 32 * 4 <= WS_XBC && WS_XBC + (size_t)M * 4096 * 2 <= WS_AB
              && WS_GA + (size_t)M * 1024 * 2 <= WS_END && WS_AB + (size_t)M * 1024 * 2 <= WS_WINA && WS_MO + (size_t)M * 1024 * 2 <= WS_AB, "ws map");
constexpr int LDS_BYTES = 147456;

__device__ __forceinline__ unsigned f2bf(float f) { unsigned u = __builtin_bit_cast(unsigned, f); return (u + 0x7fffu + ((u >> 16) & 1u)) >> 16; }
__device__ __forceinline__ unsigned pk2(float lo, float hi) { return pg8::cvt_pk_bf16(lo, hi); }
__device__ __forceinline__ float bflo(unsigned w) { return __uint_as_float(w << 16); }
__device__ __forceinline__ float bfhi(unsigned w) { return __uint_as_float(w & 0xffff0000u); }
__device__ __forceinline__ float bf1(bf16 b) { return __uint_as_float((unsigned)b << 16); }
__device__ __forceinline__ float wave_sum(float v) {
#pragma unroll
    for (int o = 1; o < 64; o <<= 1) v += __shfl_xor(v, o);
    return v;
}
#define LDS_WAIT() asm volatile("s_waitcnt lgkmcnt(0)" ::: "memory")

struct Args {
    const float *x_p, *x_s, *st_ca, *st_cm, *st_ss, *n_mix_pre, *w_in, *b_gate, *conv_a_w, *w_a_out, *conv_m_w, *conv_m_b, *dt_bias, *a_log, *d_skip, *ssm_norm, *w_ssm_out, *w_o,
        *n_mix_post, *n_ffn_pre, *w_ff1, *w_ff2, *n_ffn_post;
    float* out; unsigned char* ws;
    int coop_sync; int pad;
};

__device__ __forceinline__ void p0_transpose_item(const float* W, int Nsrc, int n0, int k0, bf16* WT, int Kld, int drow, LAS float* scr, int lane, const float* kscale) {
    if (n0 >= 0) {
        float tv[32];
#pragma unroll
        for (int i = 0; i < 32; ++i) { const int kk = 2 * i + (lane >> 5); tv[i] = W[(size_t)(k0 + kk) * Nsrc + n0 + (lane & 31)]; }
#pragma unroll
        for (int i = 0; i < 32; ++i) { const int kk = 2 * i + (lane >> 5); float v = tv[i]; if (kscale) v *= kscale[k0 + kk]; scr[kk * 33 + (lane & 31)] = v; }
    } else {
#pragma unroll 8
        for (int i = 0; i < 32; ++i) { const int kk = 2 * i + (lane >> 5); scr[kk * 33 + (lane & 31)] = 0.f; }
    }
    LDS_WAIT(); asm volatile("" ::: "memory");
    const int c = lane & 7;
#pragma unroll
    for (int j = 0; j < 4; ++j) { const int n = (lane >> 3) + 8 * j; const LAS float* s = scr + (8 * c) * 33 + n;
        u32x4 o; o.x = pk2(s[0 * 33], s[1 * 33]); o.y = pk2(s[2 * 33], s[3 * 33]); o.z = pk2(s[4 * 33], s[5 * 33]); o.w = pk2(s[6 * 33], s[7 * 33]);
        *(u32x4*)(WT + (size_t)(drow + n) * Kld + k0 + 8 * c) = o; }
    LDS_WAIT(); asm volatile("" ::: "memory");
}
__device__ __forceinline__ int win_src_col(int r) {
    if (r < 2048) return 3072 + r;
    if (r < 6144) return 5120 + (r - 2048);
    if (r < 6176) return 9216 + (r - 6144);
    if (r < 6400) return -1;
    if (r < 7424) return r - 6400;
    if (r < 8448) return 9248 + (r - 7424);
    if (r < 10496) { const int t = r - 8448, j = t >> 8, w = t & 255; return w < 128 ? 1024 + 128 * j + w : 2048 + 128 * j + (w - 128); }
    return 10272 + (r - 10496);
}
__device__ __forceinline__ const float* xrow_ptr(const Args& a, int m) { return m < M_P ? a.x_p + (size_t)m * DM : a.x_s + (size_t)(m - M_P) * DM; }

constexpr int CV_IN = (NWIN / 32) * 16, CV_A = 32 * 16, CV_B = 32 * 32, CV_O = 32 * 16, CV_1 = 128 * 16, CV_2 = 32 * 64;
constexpr int CV_EARLY = CV_IN + CV_A + CV_B + CV_O, CV_ALL = CV_EARLY + CV_1 + CV_2;
__device__ __forceinline__ void convert_items(const Args& a, LAS unsigned char* lds, int wave, int lane, int gw, int NGW, int lo, int hi) {
    LAS float* scr = (LAS float*)(lds + wave * 16384);
    unsigned char* ws = a.ws;
    constexpr int I_IN = CV_IN, I_A = CV_A, I_B = CV_B, I_O = CV_O, I_1 = CV_1;
    for (int it = lo + gw; it < hi; it += NGW) {
        int r = it;
        if (r < I_IN) { const int db = r >> 4, kb = r & 15; p0_transpose_item(a.w_in, PROJ, win_src_col(32 * db), 64 * kb, db < N1A / 32 ? (bf16*)(ws + WS_WINA) : (bf16*)(ws + WS_WINB) - (size_t)N1A * 1024, 1024, 32 * db, scr, lane, nullptr); continue; } r -= I_IN;
        if (r < I_A) { const int nb = r >> 4, kb = r & 15; p0_transpose_item(a.w_a_out, 1024, 32 * nb, 64 * kb, (bf16*)(ws + WS_WA), 1024, 32 * nb, scr, lane, nullptr); continue; } r -= I_A;
        if (r < I_B) { const int nb = r >> 5, kb = r & 31; p0_transpose_item(a.w_ssm_out, 1024, 32 * nb, 64 * kb, (bf16*)(ws + WS_WB), 2048, 32 * nb, scr, lane, a.ssm_norm); continue; } r -= I_B;
        if (r < I_O) { const int nb = r >> 4, kb = r & 15; p0_transpose_item(a.w_o, 1024, 32 * nb, 64 * kb, (bf16*)(ws + WS_WO), 1024, 32 * nb, scr, lane, nullptr); continue; } r -= I_O;
        if (r < I_1) { const int nb = r >> 4, kb = r & 15; p0_transpose_item(a.w_ff1, 4096, 32 * nb, 64 * kb, (bf16*)(ws + WS_W1), 1024, 32 * nb, scr, lane, a.n_ffn_pre); continue; } r -= I_1;
        { const int nb = r >> 6, kb = r & 63; p0_transpose_item(a.w_ff2, 1024, 32 * nb, 64 * kb, (bf16*)(ws + WS_W2), 4096, 32 * nb, scr, lane, nullptr); }
    }
}
__device__ __forceinline__ void p0_prologue(const Args& a, LAS unsigned char* lds, int wave, int lane) {
    const int gw = blockIdx.x * NWAVES + wave, NGW = gridDim.x * NWAVES;
    unsigned char* ws = a.ws;
    convert_items(a, lds, wave, lane, gw, NGW, 0, CV_IN);
    f32x4 wv[2][2];
#pragma unroll
    for (int j = 0; j < 2; ++j) { wv[j][0] = *(const f32x4*)(a.n_mix_pre + 8 * lane + 512 * j); wv[j][1] = *(const f32x4*)(a.n_mix_pre + 8 * lane + 512 * j + 4); }
    bf16* XN = (bf16*)(ws + WS_XN);
    for (int m0 = gw; m0 < M; m0 += 2 * NGW) {
        const int mm[2] = {m0, m0 + NGW < M ? m0 + NGW : m0};
        f32x4 v[2][2][2];
#pragma unroll
        for (int rr = 0; rr < 2; ++rr) { const float* xr = xrow_ptr(a, mm[rr]);
#pragma unroll
            for (int j = 0; j < 2; ++j)
#pragma unroll
                for (int e = 0; e < 2; ++e) v[rr][j][e] = __builtin_nontemporal_load((const f32x4*)(xr + 8 * lane + 512 * j + 4 * e)); }
#pragma unroll
        for (int rr = 0; rr < 2; ++rr) { float s = 0.f;
#pragma unroll
            for (int j = 0; j < 2; ++j)
#pragma unroll
                for (int e = 0; e < 2; ++e) s += (v[rr][j][e][0] * v[rr][j][e][0] + v[rr][j][e][1] * v[rr][j][e][1]) + (v[rr][j][e][2] * v[rr][j][e][2] + v[rr][j][e][3] * v[rr][j][e][3]);
            const float rstd = rsqrtf(wave_sum(s) * (1.f / DM) + EPS);
            if (lane == 0) ((float*)(ws + WS_RX))[mm[rr]] = rstd;
#pragma unroll
            for (int j = 0; j < 2; ++j) *(u32x4*)(XN + (size_t)mm[rr] * DM + 8 * lane + 512 * j) = pg8::pack8(v[rr][j][0] * rstd * wv[j][0], v[rr][j][1] * rstd * wv[j][1]); }
    }
    float* ssq1 = (float*)(ws + WS_SSQ1); float* ssq2 = (float*)(ws + WS_SSQ2);
    for (int i = blockIdx.x * 512 + threadIdx.x; i < M; i += gridDim.x * 512) { ssq1[i] = 0.f; ssq2[i] = 0.f; }
}

namespace ssd {
constexpr int CN_OFF = 0, BN_OFF = 17408, BT_OFF = 34816, XT_OFF = 53248, CB_OFF = 90112, DT_OFF = 107520, AC_OFF = 108544, SQ_OFF = 109568, ZS_OFF = 111616;
constexpr int CN_LD = 136, BT_LD = 72, XT_LD = 72, CB_LD = 68, ZS_LD = 264;
static_assert(ZS_OFF + 64 * ZS_LD * 2 <= LDS_BYTES, "ssd lds");
constexpr int PFT = 14;
#define SSD_BAR() asm volatile("s_waitcnt lgkmcnt(0)\n\ts_barrier" ::: "memory")
#define MFMA16(a, b, c) __builtin_amdgcn_mfma_f32_16x16x32_bf16((a), (b), (c), 0, 0, 0)
__device__ __forceinline__ float silu(float v) { return v * __builtin_amdgcn_rcpf(1.f + __expf(-v)); }
typedef float f32x2 __attribute__((ext_vector_type(2)));
__device__ __forceinline__ f32x2 silu2(f32x2 v) {
    f32x2 e = v * (-1.4426950408889634f); e.x = __builtin_amdgcn_exp2f(e.x); e.y = __builtin_amdgcn_exp2f(e.y); e = e + 1.0f;
    f32x2 r; r.x = __builtin_amdgcn_rcpf(e.x); r.y = __builtin_amdgcn_rcpf(e.y); return v * r;
}
__device__ __forceinline__ bf16x8 pk8(const float* v) { u32x4 w; w.x = pk2(v[0], v[1]); w.y = pk2(v[2], v[3]); w.z = pk2(v[4], v[5]); w.w = pk2(v[6], v[7]); return __builtin_bit_cast(bf16x8, w); }

__device__ __forceinline__ void unit(const Args& a, LAS unsigned char* lds, int sq, int g) {
    int tid = threadIdx.x; asm volatile("" : "+v"(tid));
    const int wid = __builtin_amdgcn_readfirstlane(tid >> 6), lane = tid & 63, r = lane & 15, q = lane >> 4;
    const int j = wid >> 1, hw = wid & 1;
    const bool samp = sq >= 16; const int sb = samp ? sq - 16 : sq;
    const int row0 = samp ? M_P + 64 * sb : 2048 * sq, nch = samp ? 1 : 32;
    const int h = 4 * g + j;
    const bf16* XBC = (const bf16*)(a.ws + WS_XBC); bf16* ZY = (bf16*)a.out; const float* DT = (const float*)(a.ws + WS_DT);
    float* o_cm = a.out + (samp ? O_CM_S : O_CM_P); float* o_ss = a.out + (samp ? O_SS_S : O_SS_P);
    LAS bf16* Cn = (LAS bf16*)(lds + CN_OFF); LAS bf16* Bn = (LAS bf16*)(lds + BN_OFF); LAS bf16* Bt = (LAS bf16*)(lds + BT_OFF); LAS bf16* Xt = (LAS bf16*)(lds + XT_OFF);
    LAS float* CB = (LAS float*)(lds + CB_OFF); LAS float* DTV = (LAS float*)(lds + DT_OFF); LAS float* AC = (LAS float*)(lds + AC_OFF); LAS float* SQ = (LAS float*)(lds + SQ_OFF);
    LAS bf16* ZS = (LAS bf16*)(lds + ZS_OFF);
    const float dsk = a.d_skip[h];

    f32x4 st[8][2];
#pragma unroll
    for (int nt = 0; nt < 8; ++nt)
#pragma unroll
        for (int pt = 0; pt < 2; ++pt) {
            if (samp) st[nt][pt] = *(const f32x4*)(a.st_ss + ((size_t)(sb * 32 + h) * 64 + 32 * hw + 16 * pt + r) * 128 + 16 * nt + 4 * q);
            else st[nt][pt] = (f32x4){0.f, 0.f, 0.f, 0.f};
        }
    const int cp = tid & 255, tb = tid >> 8, c0 = 2 * cp;
    const int col = c0 < 256 ? 256 * g + c0 : (c0 < 384 ? 2048 + 128 * g + (c0 - 256) : 3072 + 128 * g + (c0 - 384));
    float cw[4][2], cbias[2];
#pragma unroll
    for (int i = 0; i < 4; ++i) { cw[i][0] = a.conv_m_w[i * 4096 + col]; cw[i][1] = a.conv_m_w[i * 4096 + col + 1]; }
    cbias[0] = a.conv_m_b[col]; cbias[1] = a.conv_m_b[col + 1];
    const int zr = tid >> 3, zc = tid & 7;
    const int hh = 4 * g + (wid & 3);
    const float dtb = a.dt_bias[hh], aneg = -__expf(a.a_log[hh]);

    unsigned xw[3 + PFT]; float dtr = 0.f;
#define SSD_PREFETCH(cc) do { const int rowp_ = row0 + 64 * (cc); const bf16* src_ = XBC + (size_t)(rowp_ + 32 * tb) * 4096 + col; const int hv_ = (tb == 1 || (cc) > 0) ? 4096 : 0; \
        _Pragma("unroll") for (int k_ = 0; k_ < 3; ++k_) xw[k_] = *(const unsigned*)(src_ - (3 - k_) * hv_); \
        _Pragma("unroll") for (int t_ = 0; t_ < PFT; ++t_) xw[3 + t_] = *(const unsigned*)(src_ + (size_t)t_ * 4096); \
        dtr = DT[(size_t)(rowp_ + lane) * 32 + hh]; } while (0)
    SSD_PREFETCH(0);

    for (int c = 0; c < nch; ++c) {
        const int rowc = row0 + 64 * c;
        unsigned xl[32 - PFT];
        { const bf16* src = XBC + (size_t)(rowc + 32 * tb) * 4096 + col;
#pragma unroll
          for (int t = PFT; t < 32; ++t) xl[t - PFT] = *(const unsigned*)(src + (size_t)t * 4096); }
        if (wid < 4) {
            const float v = dtr + dtb;
            const float dt = v > 20.f ? v : log1pf(__expf(v));
            float ad = dt * aneg;
#pragma unroll
            for (int o = 1; o < 64; o <<= 1) { const float t = __shfl_up(ad, o); if (lane >= o) ad += t; }
            DTV[wid * 64 + lane] = dt; AC[wid * 64 + lane] = ad;
        }
        {
            f32x2 p3, p2, p1;
            const f32x2 cw0 = (f32x2){cw[0][0], cw[0][1]}, cw1 = (f32x2){cw[1][0], cw[1][1]}, cw2 = (f32x2){cw[2][0], cw[2][1]}, cw3 = (f32x2){cw[3][0], cw[3][1]}, cbv = (f32x2){cbias[0], cbias[1]};
            if (tb == 1 || c > 0) { p3 = (f32x2){bflo(xw[0]), bfhi(xw[0])}; p2 = (f32x2){bflo(xw[1]), bfhi(xw[1])}; p1 = (f32x2){bflo(xw[2]), bfhi(xw[2])}; }
            else if (samp) {
                const float* hs = a.st_cm + (size_t)sb * 3 * 4096 + col;
                p3 = (f32x2){hs[0], hs[1]}; p2 = (f32x2){hs[4096], hs[4097]}; p1 = (f32x2){hs[8192], hs[8193]};
            } else { p3 = p2 = p1 = (f32x2){0.f, 0.f}; }
            if (tb == 1 && c == nch - 1) {
#pragma unroll
                for (int k = 0; k < 3; ++k) { float* d = o_cm + (size_t)(sb * 3 + k) * 4096 + col; d[0] = bflo(xl[29 + k - PFT]); d[1] = bfhi(xl[29 + k - PFT]); }
            }
#pragma unroll
            for (int o = 0; o < 4; ++o) {
                float o0[8], o1[8];
#pragma unroll
                for (int t = 0; t < 8; ++t) {
                    const unsigned wv = (8 * o + t < PFT) ? xw[3 + ((8 * o + t) < PFT ? (8 * o + t) : 0)] : xl[(8 * o + t) >= PFT ? (8 * o + t - PFT) : 0];
                    const f32x2 xv2 = (f32x2){bflo(wv), bfhi(wv)};
                    const f32x2 ov = silu2(cw0 * p3 + (cw1 * p2 + (cw2 * p1 + (cw3 * xv2 + cbv))));
                    o0[t] = ov.x; o1[t] = ov.y;
                    p3 = p2; p2 = p1; p1 = xv2;
                }
                const int s0 = 32 * tb + 8 * o;
                if (c0 < 256) {
                    *(LAS bf16x8*)(Xt + c0 * XT_LD + s0) = pk8(o0); *(LAS bf16x8*)(Xt + (c0 + 1) * XT_LD + s0) = pk8(o1);
                } else if (c0 < 384) {
                    const int n = c0 - 256;
                    *(LAS bf16x8*)(Bt + n * BT_LD + s0) = pk8(o0); *(LAS bf16x8*)(Bt + (n + 1) * BT_LD + s0) = pk8(o1);
#pragma unroll
                    for (int t = 0; t < 8; ++t) *(LAS unsigned*)(Bn + (s0 + t) * CN_LD + n) = pk2(o0[t], o1[t]);
                } else {
                    const int n = c0 - 384;
#pragma unroll
                    for (int t = 0; t < 8; ++t) *(LAS unsigned*)(Cn + (s0 + t) * CN_LD + n) = pk2(o0[t], o1[t]);
                }
            }
        }
        u32x4 zq[4];
#pragma unroll
        for (int k = 0; k < 4; ++k) zq[k] = *(const u32x4*)(ZY + (size_t)(rowc + zr) * 2048 + 256 * g + 8 * (zc + 8 * k));
        SSD_BAR();
        SSD_PREFETCH(c + 1 < nch ? c + 1 : c);
        __builtin_amdgcn_sched_barrier(0);
        {
            const int lt = wid >> 1, st2 = (wid & 1) * 2;
            f32x4 cb0 = (f32x4){0.f, 0.f, 0.f, 0.f}, cb1 = cb0;
#pragma unroll
            for (int kk = 0; kk < 4; ++kk) {
                const bf16x8 av = *(const LAS bf16x8*)(Cn + (16 * lt + r) * CN_LD + 32 * kk + 8 * q);
                const bf16x8 b0 = *(const LAS bf16x8*)(Bn + (16 * st2 + r) * CN_LD + 32 * kk + 8 * q);
                const bf16x8 b1 = *(const LAS bf16x8*)(Bn + (16 * (st2 + 1) + r) * CN_LD + 32 * kk + 8 * q);
                cb0 = MFMA16(av, b0, cb0); cb1 = MFMA16(av, b1, cb1);
            }
#pragma unroll
            for (int i = 0; i < 4; ++i) { CB[(16 * lt + 4 * q + i) * CB_LD + 16 * st2 + r] = cb0[i]; CB[(16 * lt + 4 * q + i) * CB_LD + 16 * (st2 + 1) + r] = cb1[i]; }
        }
        f32x4 y[4][2];
#pragma unroll
        for (int lt = 0; lt < 4; ++lt) { y[lt][0] = (f32x4){0.f, 0.f, 0.f, 0.f}; y[lt][1] = y[lt][0]; }
#pragma unroll
        for (int kk = 0; kk < 4; ++kk) {
            bf16x8 hf[2];
#pragma unroll
            for (int pt = 0; pt < 2; ++pt) { float t8[8];
#pragma unroll
                for (int i = 0; i < 4; ++i) { t8[i] = st[2 * kk][pt][i]; t8[4 + i] = st[2 * kk + 1][pt][i]; }
                hf[pt] = pk8(t8); }
#pragma unroll
            for (int lt = 0; lt < 4; ++lt) {
                const s16x4 lo = *(const LAS s16x4*)(Cn + (16 * lt + r) * CN_LD + 32 * kk + 4 * q);
                const s16x4 hi = *(const LAS s16x4*)(Cn + (16 * lt + r) * CN_LD + 32 * kk + 16 + 4 * q);
                const bf16x8 av = __builtin_shufflevector(lo, hi, 0, 1, 2, 3, 4, 5, 6, 7);
                y[lt][0] = MFMA16(av, hf[0], y[lt][0]); y[lt][1] = MFMA16(av, hf[1], y[lt][1]);
            }
        }
#pragma unroll
        for (int lt = 0; lt < 4; ++lt) { const f32x4 ac = *(const LAS f32x4*)(AC + j * 64 + 16 * lt + 4 * q);
#pragma unroll
            for (int i = 0; i < 4; ++i) { const float e = __expf(ac[i]); y[lt][0][i] *= e; y[lt][1][i] *= e; } }
#pragma unroll
        for (int k = 0; k < 4; ++k) *(LAS u32x4*)(ZS + zr * ZS_LD + 8 * (zc + 8 * k)) = zq[k];
        SSD_BAR();
        {
            const float aend = AC[j * 64 + 63]; const float cdec = __expf(aend);
#pragma unroll
            for (int nt = 0; nt < 8; ++nt) { st[nt][0] *= cdec; st[nt][1] *= cdec; }
#pragma unroll
            for (int kk = 0; kk < 2; ++kk) {
                const f32x4 a0 = *(const LAS f32x4*)(AC + j * 64 + 32 * kk + 8 * q), a1 = *(const LAS f32x4*)(AC + j * 64 + 32 * kk + 8 * q + 4);
                const f32x4 d0 = *(const LAS f32x4*)(DTV + j * 64 + 32 * kk + 8 * q), d1 = *(const LAS f32x4*)(DTV + j * 64 + 32 * kk + 8 * q + 4);
                float acs[8], dts[8];
#pragma unroll
                for (int i = 0; i < 4; ++i) { acs[i] = a0[i]; acs[4 + i] = a1[i]; dts[i] = d0[i]; dts[4 + i] = d1[i]; }
                bf16x8 xf[2];
#pragma unroll
                for (int pt = 0; pt < 2; ++pt) xf[pt] = *(const LAS bf16x8*)(Xt + (j * 64 + 32 * hw + 16 * pt + r) * XT_LD + 32 * kk + 8 * q);
#pragma unroll
                for (int lt = 0; lt < 4; ++lt) {
                    if (kk == 1 && lt < 2) continue;
                    const int l = 16 * lt + r; const float al = AC[j * 64 + l];
                    const f32x4 c0v = *(const LAS f32x4*)(CB + l * CB_LD + 32 * kk + 8 * q), c1v = *(const LAS f32x4*)(CB + l * CB_LD + 32 * kk + 8 * q + 4);
                    float gv[8];
#pragma unroll
                    for (int i = 0; i < 8; ++i) { const int s = 32 * kk + 8 * q + i; const float cbv = i < 4 ? c0v[i & 3] : c1v[i & 3];
                        const float gq = cbv * __expf(al - acs[i]) * dts[i];
                        gv[i] = (kk == 0 && lt >= 2) ? gq : (s <= l ? gq : 0.f); }
                    const bf16x8 gf = pk8(gv);
                    y[lt][0] = MFMA16(gf, xf[0], y[lt][0]); y[lt][1] = MFMA16(gf, xf[1], y[lt][1]);
                }
                bf16x8 xs[2];
                float wsc[8];
#pragma unroll
                for (int i = 0; i < 8; ++i) wsc[i] = dts[i] * __expf(aend - acs[i]);
#pragma unroll
                for (int pt = 0; pt < 2; ++pt) { const u32x4 xu = __builtin_bit_cast(u32x4, xf[pt]); float t8[8];
                    t8[0] = bflo(xu.x) * wsc[0]; t8[1] = bfhi(xu.x) * wsc[1]; t8[2] = bflo(xu.y) * wsc[2]; t8[3] = bfhi(xu.y) * wsc[3];
                    t8[4] = bflo(xu.z) * wsc[4]; t8[5] = bfhi(xu.z) * wsc[5]; t8[6] = bflo(xu.w) * wsc[6]; t8[7] = bfhi(xu.w) * wsc[7];
                    xs[pt] = pk8(t8); }
#pragma unroll
                for (int nt = 0; nt < 8; ++nt) { const bf16x8 bf = *(const LAS bf16x8*)(Bt + (16 * nt + r) * BT_LD + 32 * kk + 8 * q);
                    st[nt][0] = MFMA16(bf, xs[0], st[nt][0]); st[nt][1] = MFMA16(bf, xs[1], st[nt][1]); }
            }
        }
        {
            float sq[4][4];
#pragma unroll
            for (int lt = 0; lt < 4; ++lt) {
#pragma unroll
                for (int i = 0; i < 4; ++i) sq[lt][i] = 0.f;
#pragma unroll
                for (int pt = 0; pt < 2; ++pt) {
                    const u32x2 xv = *(const LAS u32x2*)(Xt + (j * 64 + 32 * hw + 16 * pt + r) * XT_LD + 16 * lt + 4 * q);
                    const float xs4[4] = {bflo(xv.x), bfhi(xv.x), bflo(xv.y), bfhi(xv.y)};
#pragma unroll
                    for (int i = 0; i < 4; i += 2) {
                        LAS bf16* zp0 = ZS + (16 * lt + 4 * q + i) * ZS_LD + 64 * j + 32 * hw + 16 * pt + r; LAS bf16* zp1 = zp0 + ZS_LD;
                        const f32x2 zz = (f32x2){bf1(*zp0), bf1(*zp1)};
                        const f32x2 v = ((f32x2){y[lt][pt][i], y[lt][pt][i + 1]} + dsk * (f32x2){xs4[i], xs4[i + 1]}) * silu2(zz);
                        const unsigned vb = pk2(v.x, v.y); *zp0 = (bf16)(vb & 0xffffu); *zp1 = (bf16)(vb >> 16);
                        const f32x2 vr = (f32x2){bflo(vb), bfhi(vb)}; sq[lt][i] += vr.x * vr.x; sq[lt][i + 1] += vr.y * vr.y;
                    }
                }
#pragma unroll
                for (int i = 0; i < 4; ++i) { float s = sq[lt][i]; s += __shfl_xor(s, 1); s += __shfl_xor(s, 2); s += __shfl_xor(s, 4); s += __shfl_xor(s, 8); sq[lt][i] = s; }
                if (r == 0) *(LAS f32x4*)(SQ + wid * 64 + 16 * lt + 4 * q) = (f32x4){sq[lt][0], sq[lt][1], sq[lt][2], sq[lt][3]};
            }
            SSD_BAR();
            float tot = 0.f;
#pragma unroll
            for (int w = 0; w < 8; ++w) tot += SQ[w * 64 + zr];
            const float rs = rsqrtf(tot * (1.f / 256.f) + EPS);
#pragma unroll
            for (int k = 0; k < 4; ++k) { f32x4 v0, v1; pg8::unpack8(*(const LAS u32x4*)(ZS + zr * ZS_LD + 8 * (zc + 8 * k)), v0, v1);
                *(u32x4*)(ZY + (size_t)(rowc + zr) * 2048 + 256 * g + 8 * (zc + 8 * k)) = pg8::pack8(v0 * rs, v1 * rs); }
        }
    }
#undef SSD_PREFETCH
#pragma unroll
    for (int nt = 0; nt < 8; ++nt)
#pragma unroll
        for (int pt = 0; pt < 2; ++pt) *(f32x4*)(o_ss + ((size_t)(sb * 32 + h) * 64 + 32 * hw + 16 * pt + r) * 128 + 16 * nt + 4 * q) = st[nt][pt];
}
}

__device__ __forceinline__ void mixa_phase(const Args& a, int wave, int lane, int bxo, int nb) {
    const int gw = bxo * NWAVES + wave, NGW = nb * NWAVES;
    bf16* AB = (bf16*)(a.ws + WS_AB);
    for (int it0 = gw; it0 < 1056; it0 += NGW) {
        const int it = it0 >> 1, ch = 512 * (it0 & 1) + 8 * lane;
        f32x4 w0[2], w1[2], w2[2];
#pragma unroll
        for (int e = 0; e < 2; ++e) { w0[e] = *(const f32x4*)(a.conv_a_w + ch + 4 * e); w1[e] = *(const f32x4*)(a.conv_a_w + 1024 + ch + 4 * e); w2[e] = *(const f32x4*)(a.conv_a_w + 2048 + ch + 4 * e); }
        const bool samp = it >= 512; const int sb = samp ? it - 512 : it >> 5, c = samp ? 0 : it & 31, nch = samp ? 1 : 32;
        const int row = samp ? M_P + 64 * sb : 2048 * sb + 64 * c;
        const bf16* V = samp ? (const bf16*)(a.ws + WS_VS) - (size_t)M_P * 1024 : (const bf16*)(a.ws + WS_V);
        f32x4 p2[2], p1[2];
        if (c > 0) { pg8::unpack8(*(const u32x4*)(V + (size_t)(row - 2) * 1024 + ch), p2[0], p2[1]); pg8::unpack8(*(const u32x4*)(V + (size_t)(row - 1) * 1024 + ch), p1[0], p1[1]); }
        else if (samp) { const float* hs = a.st_ca + (size_t)sb * 2 * 1024 + ch; p2[0] = *(const f32x4*)hs; p2[1] = *(const f32x4*)(hs + 4); p1[0] = *(const f32x4*)(hs + 1024); p1[1] = *(const f32x4*)(hs + 1028); }
        else { p2[0] = p2[1] = p1[0] = p1[1] = (f32x4){0.f, 0.f, 0.f, 0.f}; }
        float* o_ca = a.out + (samp ? O_CA_S : O_CA_P) + (size_t)sb * 2 * 1024 + ch;
        for (int t0 = 0; t0 < 64; t0 += 8) {
            u32x4 vv[8], aa[8];
#pragma unroll
            for (int k = 0; k < 8; ++k) { vv[k] = *(const u32x4*)(V + (size_t)(row + t0 + k) * 1024 + ch); aa[k] = *(const u32x4*)(AB + (size_t)(row + t0 + k) * 1024 + ch); }
#pragma unroll
            for (int k = 0; k < 8; ++k) { const int t = t0 + k;
                f32x4 v[2], ab[2];
                pg8::unpack8(vv[k], v[0], v[1]); pg8::unpack8(aa[k], ab[0], ab[1]);
                const f32x4 u0 = ab[0] * (w0[0] * p2[0] + w1[0] * p1[0] + w2[0] * v[0]), u1 = ab[1] * (w0[1] * p2[1] + w1[1] * p1[1] + w2[1] * v[1]);
                *(u32x4*)(AB + (size_t)(row + t) * 1024 + ch) = pg8::pack8(u0, u1);
                if (c == nch - 1 && t >= 62) { *(f32x4*)(o_ca + (t - 62) * 1024) = v[0]; *(f32x4*)(o_ca + (t - 62) * 1024 + 4) = v[1]; }
                p2[0] = p1[0]; p2[1] = p1[1]; p1[0] = v[0]; p1[1] = v[1]; }
        }
    }
}

template <bool FIRST> __device__ __forceinline__ void row_phase(const Args& a, const bf16* Y, const float* SCR, int nsl, const float* SSQ, const float* wpost, bf16* HX, const float* RX, float* RH, int wave, int lane) {
    const int gw = blockIdx.x * NWAVES + wave, NGW = gridDim.x * NWAVES;
    f32x4 wp[2][2], wq[2][2];
#pragma unroll
    for (int j = 0; j < 2; ++j)
#pragma unroll
        for (int e = 0; e < 2; ++e) { wp[j][e] = *(const f32x4*)(wpost + 8 * lane + 512 * j + 4 * e); if (FIRST) { const f32x4 w = *(const f32x4*)(a.n_mix_pre + 8 * lane + 512 * j + 4 * e); wq[j][e] = (f32x4){1.f / w[0], 1.f / w[1], 1.f / w[2], 1.f / w[3]}; } }
    for (int m0 = gw; m0 < M; m0 += 2 * NGW) {
        const int mm[2] = {m0, m0 + NGW < M ? m0 + NGW : m0};
        f32x4 yq[2][2][2]; f32x4 bq[2][2][2]; float sq[2];
#pragma unroll
        for (int rr = 0; rr < 2; ++rr) { const int m = mm[rr];
            if (m < M_P) { sq[rr] = SSQ[m];
#pragma unroll
                for (int j = 0; j < 2; ++j) pg8::unpack8(*(const u32x4*)(Y + (size_t)m * DM + 8 * lane + 512 * j), yq[rr][j][0], yq[rr][j][1]);
            } else {
                const float* sr = SCR + (size_t)(m - M_P) * DM; float s = 0.f;
#pragma unroll
                for (int j = 0; j < 2; ++j)
#pragma unroll
                    for (int e = 0; e < 2; ++e) yq[rr][j][e] = (f32x4){0.f, 0.f, 0.f, 0.f};
                for (int sl = 0; sl < nsl; ++sl)
#pragma unroll
                    for (int j = 0; j < 2; ++j)
#pragma unroll
                        for (int e = 0; e < 2; ++e) yq[rr][j][e] += *(const f32x4*)(sr + (size_t)sl * 1024 * 1024 + 8 * lane + 512 * j + 4 * e);
#pragma unroll
                for (int j = 0; j < 2; ++j)
#pragma unroll
                    for (int e = 0; e < 2; ++e) { const f32x4 t = yq[rr][j][e]; s += (t[0] * t[0] + t[1] * t[1]) + (t[2] * t[2] + t[3] * t[3]); }
                sq[rr] = wave_sum(s);
            }
#pragma unroll
            for (int j = 0; j < 2; ++j) pg8::unpack8(*(const u32x4*)(HX + (size_t)m * DM + 8 * lane + 512 * j), bq[rr][j][0], bq[rr][j][1]);
            if (FIRST) { const float rinv = 1.f / RX[m];
#pragma unroll
                for (int j = 0; j < 2; ++j) { bq[rr][j][0] = bq[rr][j][0] * rinv * wq[j][0]; bq[rr][j][1] = bq[rr][j][1] * rinv * wq[j][1]; } } }
#pragma unroll
        for (int rr = 0; rr < 2; ++rr) { const int m = mm[rr];
            const float rs = rsqrtf(sq[rr] * (1.f / DM) + EPS);
            f32x4 hv[2][2]; float s2 = 0.f;
#pragma unroll
            for (int j = 0; j < 2; ++j) {
                const f32x4 y0 = yq[rr][j][0], y1 = yq[rr][j][1];
                hv[j][0] = bq[rr][j][0] + y0 * rs * wp[j][0];
                hv[j][1] = bq[rr][j][1] + y1 * rs * wp[j][1];
#pragma unroll
                for (int e = 0; e < 2; ++e) s2 += (hv[j][e][0] * hv[j][e][0] + hv[j][e][1] * hv[j][e][1]) + (hv[j][e][2] * hv[j][e][2] + hv[j][e][3] * hv[j][e][3]);
                if (FIRST) *(u32x4*)(HX + (size_t)m * DM + 8 * lane + 512 * j) = pg8::pack8(hv[j][0], hv[j][1]);
                else { __builtin_nontemporal_store(hv[j][0], (f32x4*)(a.out + (size_t)m * DM + 8 * lane + 512 * j)); __builtin_nontemporal_store(hv[j][1], (f32x4*)(a.out + (size_t)m * DM + 8 * lane + 512 * j + 4)); }
            }
            if (FIRST) { const float rh = rsqrtf(wave_sum(s2) * (1.f / DM) + EPS); if (lane == 0) RH[m] = rh; }
        }
    }
}

#define XB_TMO      128
#define XB_XCNT(j)  (256  + 64 * (j))
#define XB_XSUB(j)  (1280 + 64 * (j))
#define XB_XGEN(j)  (2304 + 64 * (j))
#define XB_TOP      3328
#define XB_TOPGEN   3392
#define XCD_BAR_WORDS 3456
#define XB_SPIN_CAP (1u << 18)

__device__ __forceinline__ unsigned xb_ld(unsigned* p)              { return __hip_atomic_load(p, __ATOMIC_RELAXED, __HIP_MEMORY_SCOPE_AGENT); }
__device__ __forceinline__ unsigned xb_add(unsigned* p, unsigned v) { return __hip_atomic_fetch_add(p, v, __ATOMIC_RELAXED, __HIP_MEMORY_SCOPE_AGENT); }
__device__ __forceinline__ unsigned xb_xcc_id() { return (unsigned)__builtin_amdgcn_s_getreg((3 << 11) | 20) & 0xFu; }
#define XB_SPIN(cond, bar) do { unsigned _sp = 0; while (cond) { __builtin_amdgcn_s_sleep(1); \
    if ((++_sp & 255u) == 0u) { if (xb_ld(&(bar)[XB_TMO])) break; if (_sp > XB_SPIN_CAP) { atomicAdd(&(bar)[XB_TMO], 1u); break; } } } } while (0)

struct XcdBarrier {
    unsigned* bar; unsigned x;
    volatile LAS unsigned* st;
};

__device__ __forceinline__ XcdBarrier xcd_barrier_post(unsigned* bar, volatile LAS unsigned* st) {
    XcdBarrier b; b.bar = bar; b.x = xb_xcc_id(); b.st = st;
    if (threadIdx.x == 0) (void)xb_add(&bar[XB_XCNT(b.x)], 1u);
    return b;
}
__device__ __forceinline__ void xcd_barrier_complete(unsigned* bar, unsigned x, unsigned& nloc, unsigned& nx) {
    const unsigned G = gridDim.x * gridDim.y * gridDim.z;
    unsigned sum, cnt, mine, sp = 0u;
    for (;;) {
        sum = 0u; cnt = 0u; mine = 0u;
#pragma unroll
        for (unsigned j = 0; j < 16; ++j) { const unsigned c = xb_ld(&bar[XB_XCNT(j)]); sum += c; cnt += (c > 0u) ? 1u : 0u; mine = (j == x) ? c : mine; }
        if (sum == G) break;
        __builtin_amdgcn_s_sleep(1);
        if ((++sp & 255u) == 0u) { if (xb_ld(&bar[XB_TMO])) break; if (sp > XB_SPIN_CAP) { atomicAdd(&bar[XB_TMO], 1u); break; } }
    }
    nloc = mine > 0u ? mine : 1u; nx = cnt > 0u ? cnt : 1u;
}

__device__ __forceinline__ void xcd_barrier(const XcdBarrier& b) {
    asm volatile("s_waitcnt vmcnt(0)" ::: "memory");
    __syncthreads();
    if (threadIdx.x == 0) {
        unsigned* bar = b.bar;
        __builtin_amdgcn_s_waitcnt(0);
        unsigned nloc = b.st[0], nx = b.st[1];
        if (nloc == 0u) { xcd_barrier_complete(bar, b.x, nloc, nx); b.st[0] = nloc; b.st[1] = nx; }
        const unsigned old = xb_add(&bar[XB_XSUB(b.x)], 1u);
        const unsigned gen = old / nloc;
        if (old + 1u == (gen + 1u) * nloc) {
            __builtin_amdgcn_fence(__ATOMIC_RELEASE, "agent");
            asm volatile("s_waitcnt vmcnt(0)" ::: "memory");
            const unsigned og = xb_add(&bar[XB_TOP], 1u);
            const unsigned tg = og / nx;
            if (og + 1u == (tg + 1u) * nx) xb_add(&bar[XB_TOPGEN], 1u);
            else XB_SPIN(xb_ld(&bar[XB_TOPGEN]) == tg, bar);
            __builtin_amdgcn_fence(__ATOMIC_ACQUIRE, "agent");
            xb_add(&bar[XB_XGEN(b.x)], 1u);
            asm volatile("s_waitcnt vmcnt(0)" ::: "memory");
        } else {
            XB_SPIN(xb_ld(&bar[XB_XGEN(b.x)]) == gen, bar);
            __builtin_amdgcn_fence(__ATOMIC_ACQUIRE, "agent");
            asm volatile("s_waitcnt vmcnt(0)" ::: "memory");
        }
    }
    __syncthreads();
}

__global__ void __launch_bounds__(NWAVES * 64, 2) mega_fwd(Args a) {
    extern __shared__ __attribute__((aligned(16))) unsigned char lds_raw[];
    LAS unsigned char* lds = (LAS unsigned char*)lds_raw;
    cg::grid_group grid = cg::this_grid();
    int tid = threadIdx.x, lane, wave;
#define FRESH_TID() do { tid = threadIdx.x; asm volatile("" : "+v"(tid)); lane = tid & 63; wave = __builtin_amdgcn_readfirstlane(tid >> 6); } while (0)
    FRESH_TID();
    const int G = gridDim.x, bx = blockIdx.x;
    unsigned char* ws = a.ws;
    bf16* ZY = (bf16*)a.out;
    volatile LAS unsigned* bst = (volatile LAS unsigned*)(lds + LDS_BYTES - 64);
    if (tid == 0) { bst[0] = 0u; bst[1] = 0u; }
    __syncthreads();
    const XcdBarrier bar = xcd_barrier_post((unsigned*)(ws + WS_BAR), bst);
#define GRID_BAR() xcd_barrier(bar)
    if (a.coop_sync) grid.sync();
    p0_prologue(a, lds, wave, lane);
    GRID_BAR();
    { pg8::Gemm g{(const bf16*)(ws + WS_XN), (const bf16*)(ws + WS_WINA), M, N1A, 1024, 1024}; pg8::StaticOrder S; S.init(M, N1A, G, bx);
      pg8::EpiP1a E{ZY, (bf16*)(ws + WS_XBC), (float*)(ws + WS_DT)};
      pg8::gemm_phase<pg8::EpiP1a, pg8::StaticOrder, true, true>(lds, g, S, E); }
    GRID_BAR();
    { const int NS = G / 2;
      if (bx >= NS) { pg8::Gemm g{(const bf16*)(ws + WS_XN), (const bf16*)(ws + WS_WINB), M, 2048, 1024, 1024}; pg8::StaticOrder S; S.init(M, 2048, G - NS, bx - NS);
             pg8::EpiP2g E{(bf16*)(ws + WS_AB), (bf16*)(ws + WS_GA), a.b_gate};
             pg8::gemm_phase<pg8::EpiP2g, pg8::StaticOrder, true, true>(lds, g, S, E);
             const int c2 = (bx - NS) >= 32 ? (bx - NS) - 32 : (bx - NS) + (G - NS) - 32;
             pg8::Gemm g2{(const bf16*)(ws + WS_XN) + (size_t)M_P * 1024, (const bf16*)(ws + WS_WINB) + (size_t)2048 * 1024, M_S, 3072, 1024, 1024}; pg8::StaticOrder S2; S2.init(M_S, 3072, G - NS, c2);
             pg8::EpiP1b E2{(bf16*)(ws + WS_VS) - (size_t)M_P * 1024, (bf16*)(ws + WS_GBS) - (size_t)M_P * 1024, a.b_gate, 128};
             pg8::gemm_phase<pg8::EpiP1b, pg8::StaticOrder, true, true>(lds, g2, S2, E2); }
      for (int u = bx; u < 256; u += G) { ssd::unit(a, lds, u >> 3, u & 7); __syncthreads(); }
      if (G < 256) for (int u = G + bx; u < 256; u += G) { ssd::unit(a, lds, u >> 3, u & 7); __syncthreads(); }
      if (bx < NS) { FRESH_TID(); convert_items(a, lds, wave, lane, bx * NWAVES + wave, NS * NWAVES, CV_IN, CV_EARLY); } }
    GRID_BAR();
    { pg8::Gemm g{(const bf16*)(ws + WS_XN), (const bf16*)(ws + WS_WINB) + (size_t)2048 * 1024, M_P, 3072, 1024, 1024}; pg8::StaticOrder S; S.init(M_P, 3072, G, bx);
      pg8::EpiP1b E{(bf16*)(ws + WS_V), (bf16*)(ws + WS_GB), a.b_gate, 0};
      pg8::gemm_phase<pg8::EpiP1b, pg8::StaticOrder, true, true>(lds, g, S, E); }
    GRID_BAR();
    { pg8::Gemm g{(const bf16*)ZY, (const bf16*)(ws + WS_WB), M, 1024, 2048, 2048}; pg8::StaticOrder S; S.init(M, 1024, G, bx);
      pg8::EpiGate<0> E{(bf16*)(ws + WS_MG), (const bf16*)(ws + WS_GB), (const bf16*)(ws + WS_GBS) - (size_t)M_P * 1024};
      pg8::gemm_phase<pg8::EpiGate<0>, pg8::StaticOrder, true, true>(lds, g, S, E); }
    { const int ntail = (G == 256) ? 16 : 0;
      FRESH_TID(); if (bx >= ntail) mixa_phase(a, wave, lane, bx - ntail, G - ntail); }
    GRID_BAR();
    { pg8::Gemm g{(const bf16*)(ws + WS_AB), (const bf16*)(ws + WS_WA), M, 1024, 1024, 1024}; pg8::StaticOrder S; S.init(M, 1024, G, bx);
      pg8::EpiGate<1> E{(bf16*)(ws + WS_MG), (const bf16*)(ws + WS_GA), (const bf16*)(ws + WS_GA)};
      pg8::gemm_phase<pg8::EpiGate<1>, pg8::StaticOrder, true, true>(lds, g, S, E); }
    { const int ntail = (G == 256) ? 16 : 0;
      FRESH_TID(); if (bx >= ntail) convert_items(a, lds, wave, lane, (bx - ntail) * NWAVES + wave, (G - ntail) * NWAVES, CV_EARLY, CV_EARLY + CV_1); }
    GRID_BAR();
    { pg8::Gemm g{(const bf16*)(ws + WS_MG), (const bf16*)(ws + WS_WO), M, 1024, 1024, 1024}; pg8::StaticOrder S; S.init(M_P, 1024, G, bx);
      pg8::EpiSsq E{(bf16*)(ws + WS_MO), (float*)(ws + WS_SSQ1)};
      pg8::gemm_phase<pg8::EpiSsq, pg8::StaticOrder, true, true>(lds, g, S, E); }
    { pg8::Gemm g{(const bf16*)(ws + WS_MG), (const bf16*)(ws + WS_WO), M, 1024, 1024, 128}; pg8::TailOrder S{G, bx, 8, 128 * 2};
      pg8::EpiPartial E{(float*)(ws + WS_SCR), 128 * 2};
      pg8::gemm_phase<pg8::EpiPartial, pg8::TailOrder, true, true>(lds, g, S, E); }
    GRID_BAR();
    FRESH_TID(); row_phase<true>(a, (const bf16*)(ws + WS_MO), (const float*)(ws + WS_SCR), 8, (const float*)(ws + WS_SSQ1), a.n_mix_post, (bf16*)(ws + WS_XN), (const float*)(ws + WS_RX), (float*)(ws + WS_RH), wave, lane);
    GRID_BAR();
    { pg8::Gemm g{(const bf16*)(ws + WS_XN), (const bf16*)(ws + WS_W1), M, FF, 1024, 1024}; pg8::StaticOrder S; S.init(M, FF, G, bx);
      pg8::EpiRelu2 E{(bf16*)(ws + WS_F), (const float*)(ws + WS_RH)};
      pg8::gemm_phase<pg8::EpiRelu2, pg8::StaticOrder, true, true>(lds, g, S, E); }
    { const int ntail = (G == 256) ? 64 : 0;
      FRESH_TID(); if (bx >= ntail) convert_items(a, lds, wave, lane, (bx - ntail) * NWAVES + wave, (G - ntail) * NWAVES, CV_EARLY + CV_1, CV_ALL); }
    GRID_BAR();
    { pg8::Gemm g{(const bf16*)(ws + WS_F), (const bf16*)(ws + WS_W2), M, 1024, FF, FF}; pg8::StaticOrder S; S.init(M_P, 1024, G, bx);
      pg8::EpiSsq E{(bf16*)(ws + WS_F2), (float*)(ws + WS_SSQ2)};
      pg8::gemm_phase<pg8::EpiSsq, pg8::StaticOrder, true, true>(lds, g, S, E); }
    { pg8::Gemm g{(const bf16*)(ws + WS_F), (const bf16*)(ws + WS_W2), M, 1024, FF, 256}; pg8::TailOrder S{G, bx, 16, 256 * 2};
      pg8::EpiPartial E{(float*)(ws + WS_SCR), 256 * 2};
      pg8::gemm_phase<pg8::EpiPartial, pg8::TailOrder, true, true>(lds, g, S, E); }
    GRID_BAR();
    FRESH_TID(); row_phase<false>(a, (const bf16*)(ws + WS_F2), (const float*)(ws + WS_SCR), 16, (const float*)(ws + WS_SSQ2), a.n_ffn_post, (bf16*)(ws + WS_XN), nullptr, nullptr, wave, lane);
}

extern "C" void kernel_launch(void* const* d_in, const int* in_sizes, int n_in, void* d_out, int out_size, void* d_ws, size_t ws_size, hipStream_t stream) {
    static int grid = 0;
    if (grid == 0) {
        if (n_in != 23 || ws_size < WS_END) { fprintf(stderr, "kernel_launch: unexpected n_in %d / ws_size %zu (need %zu)\n", n_in, ws_size, (size_t)WS_END); grid = -1; return; }
        int dev = 0, cus = 0, per_cu = 0;
        hipGetDevice(&dev); hipDeviceGetAttribute(&cus, hipDeviceAttributeMultiprocessorCount, dev);
        if (hipFuncSetAttribute((const void*)mega_fwd, hipFuncAttributeMaxDynamicSharedMemorySize, LDS_BYTES) != hipSuccess) { fprintf(stderr, "kernel_launch: hipFuncSetAttribute failed\n"); grid = -1; return; }
        if (hipOccupancyMaxActiveBlocksPerMultiprocessor(&per_cu, (const void*)mega_fwd, NWAVES * 64, LDS_BYTES) != hipSuccess || per_cu < 1) { fprintf(stderr, "kernel_launch: occupancy query says %d\n", per_cu); per_cu = 1; }
        (void)hipGetLastError();
        grid = cus * 1;
    }
    if (grid < 0) return;
    Args a{};
    const float** f = (const float**)&a;
    for (int i = 0; i < 23; ++i) f[i] = (const float*)d_in[i];
    a.out = (float*)d_out; a.ws = (unsigned char*)d_ws;
    if (hipMemsetAsync((char*)d_ws + WS_BAR, 0, XCD_BAR_WORDS * 4, stream) != hipSuccess) { fprintf(stderr, "kernel_launch: hipMemsetAsync of the barrier words failed\n"); return; }
    void* args[] = {&a};
    hipError_t e = hipLaunchCooperativeKernel((const void*)mega_fwd, dim3(grid), dim3(NWAVES * 64), args, LDS_BYTES, stream);
    if (e != hipSuccess) fprintf(stderr, "kernel_launch: cooperative launch failed: %s (grid %d)\n", hipGetErrorString(e), grid);
}
```

```cpp
#include <hip/hip_runtime.h>
#include <hip/hip_cooperative_groups.h>
#include <cstdio>
#include <cstdint>
namespace cg = cooperative_groups;
namespace pg8 {
#define PG8_LAS __attribute__((address_space(3)))
typedef unsigned short bf16_t;
typedef short bf16x8 __attribute__((ext_vector_type(8)));
typedef float f32x4 __attribute__((ext_vector_type(4)));
typedef unsigned u32x4 __attribute__((ext_vector_type(4)));
constexpr int BM = 256, BK = 64, HALF = 128, HTB = HALF * BK * 2  , STAGE_BYTES = 8 * HTB, NXCD = 8, WGM = 8;

__host__ __device__ __forceinline__ int lds_byte(int r, int c) { const int st = (r >> 4) * 2 + (c >> 5), rr = r & 15, cc = c & 31, ob = rr * 64 + cc * 2; return st * 1024 + (ob ^ (((ob >> 9) & 1) << 5)); }
__host__ __device__ __forceinline__ void stage_rc(int b, int& R, int& C) { const int st = b / 1024, sb = b % 1024, swz = sb ^ (((sb >> 9) & 1) << 5); R = (st >> 1) * 16 + swz / 64; C = (st & 1) * 32 + (swz % 64) / 2; }
__host__ __device__ __forceinline__ int perm32(int rho) { const int n = rho >> 4, i = rho & 15; return 8 * (i >> 2) + 4 * n + (i & 3); }

struct Unit { int pm, pn, kb; };
struct Gemm { const bf16_t* A; const bf16_t* Bt; int M, N, K, KL; };

struct StaticOrder {
    int nM, nN, nwg, G, c, rev;
    __host__ __device__ void init(int M, int N, int G_, int c_, int rev_ = 0) { nM = M / BM; nN = N / BM; nwg = nM * nN; G = G_; c = c_; rev = rev_; }
    __host__ __device__ bool next(int i, Unit& u) const {
        const long L = (long)i * G + c; if (L >= nwg || c < 0) return false;
        int wgid = (int)L; { const int q = nwg / NXCD, r = nwg % NXCD, xcd = wgid % NXCD, off = wgid / NXCD; wgid = (xcd < r ? xcd * (q + 1) : r * (q + 1) + (xcd - r) * q) + off; }
        const int nig = WGM * nN, gid = wgid / nig, fm = gid * WGM, gsz = (nM - fm) < WGM ? (nM - fm) : WGM;
        u.pm = fm + ((wgid % nig) % gsz); u.pn = (wgid % nig) / gsz; u.kb = 0; if (rev) u.pm = nM - 1 - u.pm; return true;
    }
    __device__ __forceinline__ void a_ready(const Unit&) const {}
    __device__ __forceinline__ void done(const Unit&) const {}
};

__device__ __forceinline__ unsigned cvt_pk_bf16(float lo, float hi) { unsigned r; asm volatile("v_cvt_pk_bf16_f32 %0, %1, %2" : "=v"(r) : "v"(lo), "v"(hi)); return r; }
__device__ __forceinline__ u32x4 pack8(f32x4 v0, f32x4 v1) { u32x4 w; w.x = cvt_pk_bf16(v0[0], v0[1]); w.y = cvt_pk_bf16(v0[2], v0[3]); w.z = cvt_pk_bf16(v1[0], v1[1]); w.w = cvt_pk_bf16(v1[2], v1[3]); return w; }
__device__ __forceinline__ float bf_lo(unsigned w) { return __uint_as_float(w << 16); }
__device__ __forceinline__ float bf_hi(unsigned w) { return __uint_as_float(w & 0xffff0000u); }
__device__ __forceinline__ void unpack8(u32x4 w, f32x4& v0, f32x4& v1) { v0 = (f32x4){bf_lo(w.x), bf_hi(w.x), bf_lo(w.y), bf_hi(w.y)}; v1 = (f32x4){bf_lo(w.z), bf_hi(w.z), bf_lo(w.w), bf_hi(w.w)}; }
__device__ __forceinline__ float sigm(float v) { return 1.0f / (1.0f + __expf(-v)); }

#define EPI_LOOP_AM _Pragma("unroll") for (int ai = 0; ai < 2; ++ai) _Pragma("unroll") for (int m = 0; m < 4; ++m)

struct EpiP1a {
    static constexpr bool PERM = true, AFTER_DRAIN = false;
    bf16_t* Z; bf16_t* XBC; float* DT;
    __device__ __forceinline__ void operator()(const f32x4 (&acc)[2][2][4][2], const Unit& u, int wr, int wc, int fr, int fq) const {
        const int row0 = u.pm * BM + wr * 64 + fr, col0 = wc * 32 + 8 * fq;
        if (u.pn < 24) {
            bf16_t* base; int ldc;
            if (u.pn < 8) { base = Z + u.pn * 256; ldc = 2048; } else { base = XBC + (u.pn - 8) * 256; ldc = 4096; }
            EPI_LOOP_AM { bf16_t* rowp = base + (size_t)(row0 + ai * HALF + m * 16) * ldc + col0;
#pragma unroll
                for (int bj = 0; bj < 2; ++bj) *(u32x4*)(rowp + bj * HALF) = pack8(acc[ai][bj][m][0], acc[ai][bj][m][1]); }
        } else if (wc == 0) {
            EPI_LOOP_AM { float* rowp = DT + (size_t)(row0 + ai * HALF + m * 16) * 32 + 8 * fq; *(f32x4*)rowp = acc[ai][0][m][0]; *(f32x4*)(rowp + 4) = acc[ai][0][m][1]; }
        }
    }
};
__device__ __forceinline__ void epi_gate_store(const f32x4 (&acc)[2][2][4][2], bf16_t* GT, const float* bias, int pt, int row0, int col0) {
    const int gc = pt * 256 + col0; bf16_t* base = GT + gc;
    f32x4 bv[2][2];
#pragma unroll
    for (int bj = 0; bj < 2; ++bj)
#pragma unroll
        for (int n = 0; n < 2; ++n) bv[bj][n] = *(const f32x4*)(bias + gc + bj * HALF + 4 * n);
    EPI_LOOP_AM { bf16_t* rowp = base + (size_t)(row0 + ai * HALF + m * 16) * 1024;
#pragma unroll
        for (int bj = 0; bj < 2; ++bj) { f32x4 v0 = acc[ai][bj][m][0] + bv[bj][0], v1 = acc[ai][bj][m][1] + bv[bj][1];
#pragma unroll
            for (int e = 0; e < 4; ++e) { v0[e] = sigm(v0[e]); v1[e] = sigm(v1[e]); }
            *(u32x4*)(rowp + bj * HALF) = pack8(v0, v1); } }
}
struct EpiP2g {
    static constexpr bool PERM = true, AFTER_DRAIN = false;
    bf16_t* AB; bf16_t* GA; const float* bgate;
    __device__ __forceinline__ void operator()(const f32x4 (&acc)[2][2][4][2], const Unit& u, int wr, int wc, int fr, int fq) const {
        const int row0 = u.pm * BM + wr * 64 + fr, col0 = wc * 32 + 8 * fq;
        if (u.pn < 4) {
            bf16_t* base = AB + u.pn * 256;
            EPI_LOOP_AM { bf16_t* rowp = base + (size_t)(row0 + ai * HALF + m * 16) * 1024 + col0;
#pragma unroll
                for (int bj = 0; bj < 2; ++bj) *(u32x4*)(rowp + bj * HALF) = pack8(acc[ai][bj][m][0], acc[ai][bj][m][1]); }
        } else epi_gate_store(acc, GA, bgate, u.pn - 4, row0, col0);
    }
};
struct EpiP1b {
    static constexpr bool PERM = true, AFTER_DRAIN = false;
    bf16_t* V; bf16_t* GB; const float* bgate; int pmo;
    __device__ __forceinline__ void operator()(const f32x4 (&acc)[2][2][4][2], const Unit& u, int wr, int wc, int fr, int fq) const {
        const int row0 = (u.pm + pmo) * BM + wr * 64 + fr, col0 = wc * 32 + 8 * fq;
        if (u.pn < 8) {
            bf16_t* base = V + u.pn * 128;
            EPI_LOOP_AM { bf16_t* rowp = base + (size_t)(row0 + ai * HALF + m * 16) * 1024 + col0;
                *(u32x4*)rowp = pack8(acc[ai][0][m][0] * acc[ai][1][m][0], acc[ai][0][m][1] * acc[ai][1][m][1]); }
        } else epi_gate_store(acc, GB, bgate + 1024, u.pn - 8, row0, col0);
    }
};
template <int MODE> struct EpiGate {
    static constexpr bool PERM = true, AFTER_DRAIN = false;
    bf16_t* O; const bf16_t* Gp; const bf16_t* Gs;
    __device__ __forceinline__ void operator()(const f32x4 (&acc)[2][2][4][2], const Unit& u, int wr, int wc, int fr, int fq) const {
        const int row0 = u.pm * BM + wr * 64 + fr, col0 = u.pn * BM + wc * 32 + 8 * fq;
        const bf16_t* G = u.pm < 128 ? Gp : Gs;
#pragma unroll
        for (int ai = 0; ai < 2; ++ai) {
            u32x4 gq[4][2], oq[4][2];
#pragma unroll
            for (int m = 0; m < 4; ++m)
#pragma unroll
                for (int bj = 0; bj < 2; ++bj) { const size_t off = (size_t)(row0 + ai * HALF + m * 16) * 1024 + col0 + bj * HALF;
                    gq[m][bj] = *(const u32x4*)(G + off); if (MODE == 1) oq[m][bj] = *(const u32x4*)(O + off); }
#pragma unroll
            for (int m = 0; m < 4; ++m)
#pragma unroll
                for (int bj = 0; bj < 2; ++bj) { const size_t off = (size_t)(row0 + ai * HALF + m * 16) * 1024 + col0 + bj * HALF;
                    f32x4 g0, g1; unpack8(gq[m][bj], g0, g1);
                    f32x4 v0 = g0 * acc[ai][bj][m][0], v1 = g1 * acc[ai][bj][m][1];
                    if (MODE == 1) { f32x4 o0, o1; unpack8(oq[m][bj], o0, o1); v0 += o0; v1 += o1; }
                    *(u32x4*)(O + off) = pack8(v0, v1); }
        }
    }
};
struct EpiSsq {
    static constexpr bool PERM = true, AFTER_DRAIN = false;
    bf16_t* O; float* SSQ;
    __device__ __forceinline__ void operator()(const f32x4 (&acc)[2][2][4][2], const Unit& u, int wr, int wc, int fr, int fq) const {
        const int row0 = u.pm * BM + wr * 64 + fr, col0 = u.pn * BM + wc * 32 + 8 * fq;
        EPI_LOOP_AM { const size_t row = (size_t)(row0 + ai * HALF + m * 16); float s = 0.f;
#pragma unroll
            for (int bj = 0; bj < 2; ++bj) { const f32x4 v0 = acc[ai][bj][m][0], v1 = acc[ai][bj][m][1];
                s += (v0[0] * v0[0] + v0[1] * v0[1]) + (v0[2] * v0[2] + v0[3] * v0[3]) + (v1[0] * v1[0] + v1[1] * v1[1]) + (v1[2] * v1[2] + v1[3] * v1[3]);
                *(u32x4*)(O + row * 1024 + col0 + bj * HALF) = pack8(v0, v1); }
            s += __shfl_xor(s, 16); s += __shfl_xor(s, 32);
            if (fq == 0) atomicAdd(SSQ + row, s); }
    }
};
struct TailOrder {
    int G, c, NS, kbytes;
    __host__ __device__ bool next(int i, Unit& u) const {
        const int L = i * G + c; if (L >= 16 * NS) return false;
        const int un = L / NS, ks = L % NS; u.pm = 128 + (un >> 2); u.pn = un & 3; u.kb = ks * kbytes; return true;
    }
    __device__ __forceinline__ void a_ready(const Unit&) const {}
    __device__ __forceinline__ void done(const Unit&) const {}
};
struct EpiPartial {
    static constexpr bool PERM = false, AFTER_DRAIN = false;
    float* SCR; int kbytes;
    __device__ __forceinline__ void operator()(const f32x4 (&acc)[2][2][4][2], const Unit& u, int wr, int wc, int fr, int fq) const {
        const int row0 = (u.pm - 128) * BM + wr * 64 + fr, col0 = u.pn * BM + wc * 32 + 4 * fq;
        float* base = SCR + (size_t)(u.kb / kbytes) * 1024 * 1024;
        EPI_LOOP_AM { float* rowp = base + (size_t)(row0 + ai * HALF + m * 16) * 1024 + col0;
#pragma unroll
            for (int bj = 0; bj < 2; ++bj)
#pragma unroll
                for (int n = 0; n < 2; ++n) *(f32x4*)(rowp + bj * HALF + n * 16) = acc[ai][bj][m][n]; }
    }
};
struct EpiRelu2 {
    static constexpr bool PERM = true, AFTER_DRAIN = false;
    bf16_t* O; const float* RS;
    __device__ __forceinline__ void operator()(const f32x4 (&acc)[2][2][4][2], const Unit& u, int wr, int wc, int fr, int fq) const {
        const int row0 = u.pm * BM + wr * 64 + fr, col0 = u.pn * BM + wc * 32 + 8 * fq;
        float rsv[2][4];
#pragma unroll
        for (int ai = 0; ai < 2; ++ai)
#pragma unroll
            for (int m = 0; m < 4; ++m) rsv[ai][m] = RS[row0 + ai * HALF + m * 16];
        EPI_LOOP_AM { bf16_t* rowp = O + (size_t)(row0 + ai * HALF + m * 16) * 4096 + col0; const float rs = rsv[ai][m];
#pragma unroll
            for (int bj = 0; bj < 2; ++bj) { f32x4 v0 = acc[ai][bj][m][0], v1 = acc[ai][bj][m][1];
#pragma unroll
                for (int e = 0; e < 4; ++e) { const float a = fmaxf(v0[e], 0.f) * rs, b = fmaxf(v1[e], 0.f) * rs; v0[e] = a * a; v1[e] = b * b; }
                *(u32x4*)(rowp + bj * HALF) = pack8(v0, v1); } }
    }
};

template <class Epi, class Sched, bool ALIGN_EPI = false, bool SP2 = false>
__device__ __forceinline__ void gemm_phase(PG8_LAS unsigned char* lds, const Gemm g, const Sched& S, const Epi& E) {
    int tid = threadIdx.x; asm volatile("" : "+v"(tid));
    const int wid = __builtin_amdgcn_readfirstlane(tid >> 6), lane = tid & 63, wr = wid >> 2, wc = wid & 3, fr = lane & 15, fq = lane >> 4;
    const int K = g.K, nt = g.KL / BK;
    unsigned voffA[2], voffB[2];
#pragma unroll
    for (int i = 0; i < 2; ++i) { int R, C; stage_rc(tid * 16 + i * 8192, R, C); const int Rb = Epi::PERM ? ((R & ~31) + perm32(R & 31)) : R;
        voffA[i] = (unsigned)(R * K + C) * 2u; voffB[i] = (unsigned)(Rb * K + C) * 2u; }
    const size_t kstep = (size_t)(BK * 2);
    const size_t hstep = (size_t)HALF * K * 2;
    const size_t tstep = 2 * hstep;
    const unsigned ldsw = (unsigned)wid * 1024u;
    const int aoff = lds_byte(wr * 64 + fr, fq * 8), boff = lds_byte(wc * 32 + fr, fq * 8);
#define PG8_SA(b, h) (((b) * 2 + (h)) * HTB)
#define PG8_SB(b, h) ((4 + (b) * 2 + (h)) * HTB)
#define PG8_STAGE(bufoff, gbase, voff) do { _Pragma("unroll") for (int _i = 0; _i < 2; ++_i) \
        __builtin_amdgcn_global_load_lds((const unsigned*)((const char*)(gbase) + (voff)[_i]), (PG8_LAS unsigned*)(lds + (bufoff) + ldsw + _i * 8192), 16, 0, 0); } while (0)
#define PG8_LDA(dst, b, h) do { _Pragma("unroll") for (int m = 0; m < 4; ++m) _Pragma("unroll") for (int k = 0; k < 2; ++k) dst[m][k] = *(const PG8_LAS bf16x8*)(lds + PG8_SA(b, h) + aoff + m * 2048 + k * 1024); } while (0)
#define PG8_LDB(dst, b, h) do { _Pragma("unroll") for (int n = 0; n < 2; ++n) _Pragma("unroll") for (int k = 0; k < 2; ++k) dst[n][k] = *(const PG8_LAS bf16x8*)(lds + PG8_SB(b, h) + boff + n * 2048 + k * 1024); } while (0)
#define PG8_MMA(ai, bj, At, Bt) do { __builtin_amdgcn_s_setprio(1); _Pragma("unroll") for (int m = 0; m < 4; ++m) _Pragma("unroll") for (int n = 0; n < 2; ++n) _Pragma("unroll") for (int k = 0; k < 2; ++k) \
        acc[ai][bj][m][n] = __builtin_amdgcn_mfma_f32_16x16x32_bf16(Bt[n][k], At[m][k], acc[ai][bj][m][n], 0, 0, 0); __builtin_amdgcn_s_setprio(0); } while (0)
#define PG8_WAIT_V(n) asm volatile("s_waitcnt vmcnt(" #n ")" ::: "memory")
#define PG8_WAIT_L(n) asm volatile("s_waitcnt lgkmcnt(" #n ")" ::: "memory")
#define PG8_BAR __builtin_amdgcn_s_barrier()
#define PG8_SCHED __builtin_amdgcn_sched_barrier(0)
    Unit cur, nxt; int ui = 0;
    if (!S.next(0, cur)) return;
    f32x4 acc[2][2][4][2];
#pragma unroll
    for (int a = 0; a < 2; ++a)
#pragma unroll
        for (int b = 0; b < 2; ++b)
#pragma unroll
            for (int m = 0; m < 4; ++m)
#pragma unroll
                for (int n = 0; n < 2; ++n) acc[a][b][m][n] = (f32x4){0.f, 0.f, 0.f, 0.f};
    bf16x8 At[4][2], B0[2][2], B1[2][2];
    const char* cA = (const char*)g.A + (size_t)cur.pm * tstep + cur.kb; const char* cB = (const char*)g.Bt + (size_t)cur.pn * tstep + cur.kb;
    S.a_ready(cur);
    if constexpr (SP2) {
        PG8_STAGE(PG8_SB(0, 0), cB, voffB); PG8_STAGE(PG8_SB(0, 1), cB + hstep, voffB); PG8_STAGE(PG8_SA(0, 0), cA, voffA); PG8_STAGE(PG8_SA(0, 1), cA + hstep, voffA);
        if (wr == 1) PG8_BAR;
        PG8_WAIT_V(2); PG8_BAR;
        PG8_STAGE(PG8_SB(1, 0), cB + kstep, voffB); PG8_STAGE(PG8_SA(1, 0), cA + kstep, voffA); PG8_STAGE(PG8_SB(1, 1), cB + hstep + kstep, voffB);
        PG8_WAIT_V(6); PG8_BAR;
    } else {
        PG8_STAGE(PG8_SB(0, 0), cB, voffB); PG8_STAGE(PG8_SA(0, 0), cA, voffA); PG8_STAGE(PG8_SB(0, 1), cB + hstep, voffB); PG8_STAGE(PG8_SA(0, 1), cA + hstep, voffA);
        if (wr == 1) PG8_BAR;
        PG8_WAIT_V(4); PG8_BAR;
        PG8_STAGE(PG8_SB(1, 0), cB + kstep, voffB); PG8_STAGE(PG8_SA(1, 0), cA + kstep, voffA); PG8_STAGE(PG8_SB(1, 1), cB + hstep + kstep, voffB);
        PG8_WAIT_V(6); PG8_BAR;
    }
    for (;;) {
        const bool has_next = S.next(ui + 1, nxt);
        const char* nA = has_next ? (const char*)g.A + (size_t)nxt.pm * tstep + nxt.kb : cA; const char* nB = has_next ? (const char*)g.Bt + (size_t)nxt.pn * tstep + nxt.kb : cB;
        for (int t = 0; t < nt; t += 2) {
            const bool last = (t == nt - 2);
            const char* a1 = cA + (size_t)(t + 1) * kstep;
            const char* a2 = last ? nA : cA + (size_t)(t + 2) * kstep; const char* b2 = last ? nB : cB + (size_t)(t + 2) * kstep;
            const char* a3 = a2 + kstep; const char* b3 = b2 + kstep;
            if (last && has_next) S.a_ready(nxt);
            if constexpr (SP2) {
            PG8_LDB(B0, 0, 0); PG8_LDB(B1, 0, 1); PG8_SCHED; PG8_LDA(At, 0, 0); PG8_STAGE(PG8_SA(1, 1), a1 + hstep, voffA);
            PG8_WAIT_V(8); PG8_WAIT_L(0); PG8_BAR; PG8_MMA(0, 0, At, B0); PG8_MMA(0, 1, At, B1); PG8_BAR; PG8_SCHED;
            PG8_LDA(At, 0, 1); PG8_STAGE(PG8_SB(0, 0), b2, voffB); PG8_STAGE(PG8_SB(0, 1), b2 + hstep, voffB); PG8_STAGE(PG8_SA(0, 0), a2, voffA);
            PG8_WAIT_V(8); PG8_WAIT_L(0); PG8_BAR; PG8_MMA(1, 0, At, B0); PG8_MMA(1, 1, At, B1); PG8_BAR; PG8_SCHED;
            PG8_LDB(B0, 1, 0); PG8_LDB(B1, 1, 1); PG8_SCHED; PG8_LDA(At, 1, 0); PG8_STAGE(PG8_SA(0, 1), a2 + hstep, voffA);
            PG8_WAIT_V(8); PG8_WAIT_L(0); PG8_BAR; PG8_MMA(0, 0, At, B0); PG8_MMA(0, 1, At, B1); PG8_BAR; PG8_SCHED;
            PG8_LDA(At, 1, 1); PG8_STAGE(PG8_SB(1, 0), b3, voffB); PG8_STAGE(PG8_SB(1, 1), b3 + hstep, voffB); PG8_STAGE(PG8_SA(1, 0), a3, voffA);
            PG8_WAIT_V(8); PG8_WAIT_L(0); PG8_BAR; PG8_MMA(1, 0, At, B0); PG8_MMA(1, 1, At, B1); PG8_BAR; PG8_SCHED;
            } else {
            PG8_LDB(B0, 0, 0); PG8_SCHED; PG8_LDA(At, 0, 0); PG8_STAGE(PG8_SA(1, 1), a1 + hstep, voffA);
            PG8_WAIT_L(8); PG8_BAR; PG8_WAIT_L(0); PG8_MMA(0, 0, At, B0); PG8_BAR; PG8_SCHED;
            PG8_LDB(B1, 0, 1); PG8_STAGE(PG8_SB(0, 0), b2, voffB);
            PG8_BAR; PG8_WAIT_L(0); PG8_MMA(0, 1, At, B1); PG8_BAR;
            PG8_LDA(At, 0, 1); PG8_STAGE(PG8_SA(0, 0), a2, voffA);
            PG8_BAR; PG8_WAIT_L(0); PG8_MMA(1, 0, At, B0); PG8_BAR; PG8_SCHED;
            PG8_STAGE(PG8_SB(0, 1), b2 + hstep, voffB);
            PG8_WAIT_V(6); PG8_BAR; PG8_MMA(1, 1, At, B1); PG8_BAR;
            PG8_LDB(B0, 1, 0); PG8_SCHED; PG8_LDA(At, 1, 0); PG8_STAGE(PG8_SA(0, 1), a2 + hstep, voffA);
            PG8_WAIT_L(8); PG8_BAR; PG8_WAIT_L(0); PG8_MMA(0, 0, At, B0); PG8_BAR; PG8_SCHED;
            PG8_LDB(B1, 1, 1); PG8_STAGE(PG8_SB(1, 0), b3, voffB);
            PG8_BAR; PG8_WAIT_L(0); PG8_MMA(0, 1, At, B1); PG8_BAR;
            PG8_LDA(At, 1, 1); PG8_STAGE(PG8_SA(1, 0), a3, voffA);
            PG8_BAR; PG8_WAIT_L(0); PG8_MMA(1, 0, At, B0); PG8_BAR; PG8_SCHED;
            PG8_STAGE(PG8_SB(1, 1), b3 + hstep, voffB);
            PG8_WAIT_V(6); PG8_BAR; PG8_MMA(1, 1, At, B1); PG8_BAR;
            }
        }
        if constexpr (ALIGN_EPI) { if (wr == 0) PG8_BAR; }
        if constexpr (!Epi::AFTER_DRAIN) { E(acc, cur, wr, wc, fr, fq); S.done(cur); }
        if (!has_next) break;
#pragma unroll
        for (int a = 0; a < 2; ++a)
#pragma unroll
            for (int b = 0; b < 2; ++b)
#pragma unroll
                for (int m = 0; m < 4; ++m)
#pragma unroll
                    for (int n = 0; n < 2; ++n) acc[a][b][m][n] = (f32x4){0.f, 0.f, 0.f, 0.f};
        cur = nxt; cA = nA; cB = nB; ++ui;
        if constexpr (ALIGN_EPI) { if (wr == 1) PG8_BAR; }
    }
    PG8_WAIT_V(0);
    if constexpr (!ALIGN_EPI) { if (wr == 0) PG8_BAR; }
    PG8_BAR;
    if constexpr (Epi::AFTER_DRAIN) { E.fused(acc, cur, wr, wc, fr, fq, lds, wid, lane); S.done(cur); }
#undef PG8_SA
#undef PG8_SB
#undef PG8_STAGE
#undef PG8_LDA
#undef PG8_LDB
#undef PG8_MMA
#undef PG8_WAIT_V
#undef PG8_WAIT_L
#undef PG8_BAR
#undef PG8_SCHED
}
}

#define LAS __attribute__((address_space(3)))
typedef unsigned short bf16;
typedef float f32x4 __attribute__((ext_vector_type(4)));
typedef short bf16x8 __attribute__((ext_vector_type(8)));
typedef short s16x4 __attribute__((ext_vector_type(4)));
typedef unsigned u32x4 __attribute__((ext_vector_type(4)));
typedef unsigned u32x2 __attribute__((ext_vector_type(2)));
constexpr int NWAVES = 8;
constexpr int DM = 1024, M_P = 16 * 2048, M_S = 16 * 64, M = M_P + M_S;
constexpr int PROJ = 11296, DI = 2048, NH = 32, NG = 8, DS = 128, CD = 4096, FF = 4096;
constexpr int N1A = 6400, N1B = 5120, NWIN = N1A + N1B;
constexpr float EPS = 1e-6f;
constexpr size_t O_Y = 0, O_CA_P = (size_t)M * DM, O_CM_P = O_CA_P + 16 * 2 * 1024, O_SS_P = O_CM_P + 16 * 3 * 4096, O_CA_S = O_SS_P + (size_t)16 * 32 * 64 * 128,
                 O_CM_S = O_CA_S + 16 * 2 * 1024, O_SS_S = O_CM_S + 16 * 3 * 4096;
constexpr size_t MiB = 1u << 20;
constexpr size_t WS_SSQ1 = 0, WS_SSQ2 = 256 * 1024, WS_BAR = 512 * 1024, WS_RX = 576 * 1024  , WS_RH = 768 * 1024  ;
constexpr size_t WS_WA = 1 * MiB;
constexpr size_t WS_WB = WS_WA + 2 * MiB;
constexpr size_t WS_WO = WS_WB + 4 * MiB;
constexpr size_t WS_W1 = WS_WO + 2 * MiB;
constexpr size_t WS_W2 = WS_W1 + 8 * MiB;
constexpr size_t WS_WINB = 25 * MiB;
constexpr size_t WS_XN = 35 * MiB;
constexpr size_t WS_DT = 101 * MiB;
constexpr size_t WS_XBC = 106 * MiB;
constexpr size_t WS_AB = 370 * MiB, WS_GA = 436 * MiB;
constexpr size_t WS_WINA = 512 * MiB - (size_t)N1A * 1024 * 2;
constexpr size_t WS_V = WS_XBC, WS_GB = WS_V + 66 * MiB, WS_MG = WS_GB + 66 * MiB, WS_MO = WS_MG + 66 * MiB;
constexpr size_t WS_F = WS_XBC, WS_F2 = WS_AB;
constexpr size_t WS_SCR = 436 * MiB;
constexpr size_t WS_VS = 502 * MiB, WS_GBS = 504 * MiB;
constexpr size_t WS_END = 512 * MiB;
static_assert(WS_W2 + 8 * MiB <= WS_WINB && WS_WINB + (size_t)N1B * 1024 * 2 <= WS_XN && WS_XN + (size_t)M * 1024 * 2 <= WS_DT && WS_DT + (size_t)M * 32 * 4 <= WS_XBC && WS_XBC + (size_t)M * 4096 * 2 <= WS_AB
              && WS_GA + (size_t)M * 1024 * 2 <= WS_END && WS_AB + (size_t)M * 1024 * 2 <= WS_WINA && WS_MO + (size_t)M * 1024 * 2 <= WS_AB, "ws map");
constexpr int LDS_BYTES = 147456;

__device__ __forceinline__ unsigned f2bf(float f) { unsigned u = __builtin_bit_cast(unsigned, f); return (u + 0x7fffu + ((u >> 16) & 1u)) >> 16; }
__device__ __forceinline__ unsigned pk2(float lo, float hi) { return pg8::cvt_pk_bf16(lo, hi); }
__device__ __forceinline__ float bflo(unsigned w) { return __uint_as_float(w << 16); }
__device__ __forceinline__ float bfhi(unsigned w) { return __uint_as_float(w & 0xffff0000u); }
__device__ __forceinline__ float bf1(bf16 b) { return __uint_as_float((unsigned)b << 16); }
__device__ __forceinline__ float wave_sum(float v) {
#pragma unroll
    for (int o = 1; o < 64; o <<= 1) v += __shfl_xor(v, o);
    return v;
}
#define LDS_WAIT() asm volatile("s_waitcnt lgkmcnt(0)" ::: "memory")

struct Args {
    const float *x_p, *x_s, *st_ca, *st_cm, *st_ss, *n_mix_pre, *w_in, *b_gate, *conv_a_w, *w_a_out, *conv_m_w, *conv_m_b, *dt_bias, *a_log, *d_skip, *ssm_norm, *w_ssm_out, *w_o,
        *n_mix_post, *n_ffn_pre, *w_ff1, *w_ff2, *n_ffn_post;
    float* out; unsigned char* ws;
    int coop_sync; int pad;
};

__device__ __forceinline__ void p0_transpose_item(const float* W, int Nsrc, int n0, int k0, bf16* WT, int Kld, int drow, LAS float* scr, int lane, const float* kscale) {
    if (n0 >= 0) {
        float tv[32];
#pragma unroll
        for (int i = 0; i < 32; ++i) { const int kk = 2 * i + (lane >> 5); tv[i] = W[(size_t)(k0 + kk) * Nsrc + n0 + (lane & 31)]; }
#pragma unroll
        for (int i = 0; i < 32; ++i) { const int kk = 2 * i + (lane >> 5); float v = tv[i]; if (kscale) v *= kscale[k0 + kk]; scr[kk * 33 + (lane & 31)] = v; }
    } else {
#pragma unroll 8
        for (int i = 0; i < 32; ++i) { const int kk = 2 * i + (lane >> 5); scr[kk * 33 + (lane & 31)] = 0.f; }
    }
    LDS_WAIT(); asm volatile("" ::: "memory");
    const int c = lane & 7;
#pragma unroll
    for (int j = 0; j < 4; ++j) { const int n = (lane >> 3) + 8 * j; const LAS float* s = scr + (8 * c) * 33 + n;
        u32x4 o; o.x = pk2(s[0 * 33], s[1 * 33]); o.y = pk2(s[2 * 33], s[3 * 33]); o.z = pk2(s[4 * 33], s[5 * 33]); o.w = pk2(s[6 * 33], s[7 * 33]);
        *(u32x4*)(WT + (size_t)(drow + n) * Kld + k0 + 8 * c) = o; }
    LDS_WAIT(); asm volatile("" ::: "memory");
}
__device__ __forceinline__ int win_src_col(int r) {
    if (r < 2048) return 3072 + r;
    if (r < 6144) return 5120 + (r - 2048);
    if (r < 6176) return 9216 + (r - 6144);
    if (r < 6400) return -1;
    if (r < 7424) return r - 6400;
    if (r < 8448) return 9248 + (r - 7424);
    if (r < 10496) { const int t = r - 8448, j = t >> 8, w = t & 255; return w < 128 ? 1024 + 128 * j + w : 2048 + 128 * j + (w - 128); }
    return 10272 + (r - 10496);
}
__device__ __forceinline__ const float* xrow_ptr(const Args& a, int m) { return m < M_P ? a.x_p + (size_t)m * DM : a.x_s + (size_t)(m - M_P) * DM; }

constexpr int CV_IN = (NWIN / 32) * 16, CV_A = 32 * 16, CV_B = 32 * 32, CV_O = 32 * 16, CV_1 = 128 * 16, CV_2 = 32 * 64;
constexpr int CV_EARLY = CV_IN + CV_A + CV_B + CV_O, CV_ALL = CV_EARLY + CV_1 + CV_2;
__device__ __forceinline__ void convert_items(const Args& a, LAS unsigned char* lds, int wave, int lane, int gw, int NGW, int lo, int hi) {
    LAS float* scr = (LAS float*)(lds + wave * 16384);
    unsigned char* ws = a.ws;
    constexpr int I_IN = CV_IN, I_A = CV_A, I_B = CV_B, I_O = CV_O, I_1 = CV_1;
    for (int it = lo + gw; it < hi; it += NGW) {
        int r = it;
        if (r < I_IN) { const int db = r >> 4, kb = r & 15; p0_transpose_item(a.w_in, PROJ, win_src_col(32 * db), 64 * kb, db < N1A / 32 ? (bf16*)(ws + WS_WINA) : (bf16*)(ws + WS_WINB) - (size_t)N1A * 1024, 1024, 32 * db, scr, lane, nullptr); continue; } r -= I_IN;
        if (r < I_A) { const int nb = r >> 4, kb = r & 15; p0_transpose_item(a.w_a_out, 1024, 32 * nb, 64 * kb, (bf16*)(ws + WS_WA), 1024, 32 * nb, scr, lane, nullptr); continue; } r -= I_A;
        if (r < I_B) { const int nb = r >> 5, kb = r & 31; p0_transpose_item(a.w_ssm_out, 1024, 32 * nb, 64 * kb, (bf16*)(ws + WS_WB), 2048, 32 * nb, scr, lane, a.ssm_norm); continue; } r -= I_B;
        if (r < I_O) { const int nb = r >> 4, kb = r & 15; p0_transpose_item(a.w_o, 1024, 32 * nb, 64 * kb, (bf16*)(ws + WS_WO), 1024, 32 * nb, scr, lane, nullptr); continue; } r -= I_O;
        if (r < I_1) { const int nb = r >> 4, kb = r & 15; p0_transpose_item(a.w_ff1, 4096, 32 * nb, 64 * kb, (bf16*)(ws + WS_W1), 1024, 32 * nb, scr, lane, a.n_ffn_pre); continue; } r -= I_1;
        { const int nb = r >> 6, kb = r & 63; p0_transpose_item(a.w_ff2, 1024, 32 * nb, 64 * kb, (bf16*)(ws + WS_W2), 4096, 32 * nb, scr, lane, nullptr); }
    }
}
__device__ __forceinline__ void p0_prologue(const Args& a, LAS unsigned char* lds, int wave, int lane) {
    const int gw = blockIdx.x * NWAVES + wave, NGW = gridDim.x * NWAVES;
    unsigned char* ws = a.ws;
    convert_items(a, lds, wave, lane, gw, NGW, 0, CV_EARLY);
    f32x4 wv[2][2];
#pragma unroll
    for (int j = 0; j < 2; ++j) { wv[j][0] = *(const f32x4*)(a.n_mix_pre + 8 * lane + 512 * j); wv[j][1] = *(const f32x4*)(a.n_mix_pre + 8 * lane + 512 * j + 4); }
    bf16* XN = (bf16*)(ws + WS_XN);
    for (int m0 = gw; m0 < M; m0 += 2 * NGW) {
        const int mm[2] = {m0, m0 + NGW < M ? m0 + NGW : m0};
        f32x4 v[2][2][2];
#pragma unroll
        for (int rr = 0; rr < 2; ++rr) { const float* xr = xrow_ptr(a, mm[rr]);
#pragma unroll
            for (int j = 0; j < 2; ++j)
#pragma unroll
                for (int e = 0; e < 2; ++e) v[rr][j][e] = __builtin_nontemporal_load((const f32x4*)(xr + 8 * lane + 512 * j + 4 * e)); }
#pragma unroll
        for (int rr = 0; rr < 2; ++rr) { float s = 0.f;
#pragma unroll
            for (int j = 0; j < 2; ++j)
#pragma unroll
                for (int e = 0; e < 2; ++e) s += (v[rr][j][e][0] * v[rr][j][e][0] + v[rr][j][e][1] * v[rr][j][e][1]) + (v[rr][j][e][2] * v[rr][j][e][2] + v[rr][j][e][3] * v[rr][j][e][3]);
            const float rstd = rsqrtf(wave_sum(s) * (1.f / DM) + EPS);
            if (lane == 0) ((float*)(ws + WS_RX))[mm[rr]] = rstd;
#pragma unroll
            for (int j = 0; j < 2; ++j) *(u32x4*)(XN + (size_t)mm[rr] * DM + 8 * lane + 512 * j) = pg8::pack8(v[rr][j][0] * rstd * wv[j][0], v[rr][j][1] * rstd * wv[j][1]); }
    }
    float* ssq1 = (float*)(ws + WS_SSQ1); float* ssq2 = (float*)(ws + WS_SSQ2);
    for (int i = blockIdx.x * 512 + threadIdx.x; i < M; i += gridDim.x * 512) { ssq1[i] = 0.f; ssq2[i] = 0.f; }
}

namespace ssd {
constexpr int CN_OFF = 0, BN_OFF = 17408, BT_OFF = 34816, XT_OFF = 53248, CB_OFF = 90112, DT_OFF = 107520, AC_OFF = 108544, SQ_OFF = 109568, ZS_OFF = 111616;
constexpr int CN_LD = 136, BT_LD = 72, XT_LD = 72, CB_LD = 68, ZS_LD = 264;
static_assert(ZS_OFF + 64 * ZS_LD * 2 <= LDS_BYTES, "ssd lds");
constexpr int PFT = 14;
#define SSD_BAR() asm volatile("s_waitcnt lgkmcnt(0)\n\ts_barrier" ::: "memory")
#define MFMA16(a, b, c) __builtin_amdgcn_mfma_f32_16x16x32_bf16((a), (b), (c), 0, 0, 0)
__device__ __forceinline__ float silu(float v) { return v * __builtin_amdgcn_rcpf(1.f + __expf(-v)); }
typedef float f32x2 __attribute__((ext_vector_type(2)));
__device__ __forceinline__ f32x2 silu2(f32x2 v) {
    f32x2 e = v * (-1.4426950408889634f); e.x = __builtin_amdgcn_exp2f(e.x); e.y = __builtin_amdgcn_exp2f(e.y); e = e + 1.0f;
    f32x2 r; r.x = __builtin_amdgcn_rcpf(e.x); r.y = __builtin_amdgcn_rcpf(e.y); return v * r;
}
__device__ __forceinline__ bf16x8 pk8(const float* v) { u32x4 w; w.x = pk2(v[0], v[1]); w.y = pk2(v[2], v[3]); w.z = pk2(v[4], v[5]); w.w = pk2(v[6], v[7]); return __builtin_bit_cast(bf16x8, w); }

__device__ __forceinline__ void unit(const Args& a, LAS unsigned char* lds, int sq, int g) {
    int tid = threadIdx.x; asm volatile("" : "+v"(tid));
    const int wid = __builtin_amdgcn_readfirstlane(tid >> 6), lane = tid & 63, r = lane & 15, q = lane >> 4;
    const int j = wid >> 1, hw = wid & 1;
    const bool samp = sq >= 16; const int sb = samp ? sq - 16 : sq;
    const int row0 = samp ? M_P + 64 * sb : 2048 * sq, nch = samp ? 1 : 32;
    const int h = 4 * g + j;
    const bf16* XBC = (const bf16*)(a.ws + WS_XBC); bf16* ZY = (bf16*)a.out; const float* DT = (const float*)(a.ws + WS_DT);
    float* o_cm = a.out + (samp ? O_CM_S : O_CM_P); float* o_ss = a.out + (samp ? O_SS_S : O_SS_P);
    LAS bf16* Cn = (LAS bf16*)(lds + CN_OFF); LAS bf16* Bn = (LAS bf16*)(lds + BN_OFF); LAS bf16* Bt = (LAS bf16*)(lds + BT_OFF); LAS bf16* Xt = (LAS bf16*)(lds + XT_OFF);
    LAS float* CB = (LAS float*)(lds + CB_OFF); LAS float* DTV = (LAS float*)(lds + DT_OFF); LAS float* AC = (LAS float*)(lds + AC_OFF); LAS float* SQ = (LAS float*)(lds + SQ_OFF);
    LAS bf16* ZS = (LAS bf16*)(lds + ZS_OFF);
    const float dsk = a.d_skip[h];

    f32x4 st[8][2];
#pragma unroll
    for (int nt = 0; nt < 8; ++nt)
#pragma unroll
        for (int pt = 0; pt < 2; ++pt) {
            if (samp) st[nt][pt] = *(const f32x4*)(a.st_ss + ((size_t)(sb * 32 + h) * 64 + 32 * hw + 16 * pt + r) * 128 + 16 * nt + 4 * q);
            else st[nt][pt] = (f32x4){0.f, 0.f, 0.f, 0.f};
        }
    const int cp = tid & 255, tb = tid >> 8, c0 = 2 * cp;
    const int col = c0 < 256 ? 256 * g + c0 : (c0 < 384 ? 2048 + 128 * g + (c0 - 256) : 3072 + 128 * g + (c0 - 384));
    float cw[4][2], cbias[2];
#pragma unroll
    for (int i = 0; i < 4; ++i) { cw[i][0] = a.conv_m_w[i * 4096 + col]; cw[i][1] = a.conv_m_w[i * 4096 + col + 1]; }
    cbias[0] = a.conv_m_b[col]; cbias[1] = a.conv_m_b[col + 1];
    const int zr = tid >> 3, zc = tid & 7;
    const int hh = 4 * g + (wid & 3);
    const float dtb = a.dt_bias[hh], aneg = -__expf(a.a_log[hh]);

    unsigned xw[3 + PFT]; float dtr = 0.f;
#define SSD_PREFETCH(cc) do { const int rowp_ = row0 + 64 * (cc); const bf16* src_ = XBC + (size_t)(rowp_ + 32 * tb) * 4096 + col; const int hv_ = (tb == 1 || (cc) > 0) ? 4096 : 0; \
        _Pragma("unroll") for (int k_ = 0; k_ < 3; ++k_) xw[k_] = *(const unsigned*)(src_ - (3 - k_) * hv_); \
        _Pragma("unroll") for (int t_ = 0; t_ < PFT; ++t_) xw[3 + t_] = *(const unsigned*)(src_ + (size_t)t_ * 4096); \
        dtr = DT[(size_t)(rowp_ + lane) * 32 + hh]; } while (0)
    SSD_PREFETCH(0);

    for (int c = 0; c < nch; ++c) {
        const int rowc = row0 + 64 * c;
        unsigned xl[32 - PFT];
        { const bf16* src = XBC + (size_t)(rowc + 32 * tb) * 4096 + col;
#pragma unroll
          for (int t = PFT; t < 32; ++t) xl[t - PFT] = *(const unsigned*)(src + (size_t)t * 4096); }
        if (wid < 4) {
            const float v = dtr + dtb;
            const float dt = v > 20.f ? v : log1pf(__expf(v));
            float ad = dt * aneg;
#pragma unroll
            for (int o = 1; o < 64; o <<= 1) { const float t = __shfl_up(ad, o); if (lane >= o) ad += t; }
            DTV[wid * 64 + lane] = dt; AC[wid * 64 + lane] = ad;
        }
        {
            f32x2 p3, p2, p1;
            const f32x2 cw0 = (f32x2){cw[0][0], cw[0][1]}, cw1 = (f32x2){cw[1][0], cw[1][1]}, cw2 = (f32x2){cw[2][0], cw[2][1]}, cw3 = (f32x2){cw[3][0], cw[3][1]}, cbv = (f32x2){cbias[0], cbias[1]};
            if (tb == 1 || c > 0) { p3 = (f32x2){bflo(xw[0]), bfhi(xw[0])}; p2 = (f32x2){bflo(xw[1]), bfhi(xw[1])}; p1 = (f32x2){bflo(xw[2]), bfhi(xw[2])}; }
            else if (samp) {
                const float* hs = a.st_cm + (size_t)sb * 3 * 4096 + col;
                p3 = (f32x2){hs[0], hs[1]}; p2 = (f32x2){hs[4096], hs[4097]}; p1 = (f32x2){hs[8192], hs[8193]};
            } else { p3 = p2 = p1 = (f32x2){0.f, 0.f}; }
            if (tb == 1 && c == nch - 1) {
#pragma unroll
                for (int k = 0; k < 3; ++k) { float* d = o_cm + (size_t)(sb * 3 + k) * 4096 + col; d[0] = bflo(xl[29 + k - PFT]); d[1] = bfhi(xl[29 + k - PFT]); }
            }
#pragma unroll
            for (int o = 0; o < 4; ++o) {
                float o0[8], o1[8];
#pragma unroll
                for (int t = 0; t < 8; ++t) {
                    const unsigned wv = (8 * o + t < PFT) ? xw[3 + ((8 * o + t) < PFT ? (8 * o + t) : 0)] : xl[(8 * o + t) >= PFT ? (8 * o + t - PFT) : 0];
                    const f32x2 xv2 = (f32x2){bflo(wv), bfhi(wv)};
                    const f32x2 ov = silu2(cw0 * p3 + (cw1 * p2 + (cw2 * p1 + (cw3 * xv2 + cbv))));
                    o0[t] = ov.x; o1[t] = ov.y;
                    p3 = p2; p2 = p1; p1 = xv2;
                }
                const int s0 = 32 * tb + 8 * o;
                if (c0 < 256) {
                    *(LAS bf16x8*)(Xt + c0 * XT_LD + s0) = pk8(o0); *(LAS bf16x8*)(Xt + (c0 + 1) * XT_LD + s0) = pk8(o1);
                } else if (c0 < 384) {
                    const int n = c0 - 256;
                    *(LAS bf16x8*)(Bt + n * BT_LD + s0) = pk8(o0); *(LAS bf16x8*)(Bt + (n + 1) * BT_LD + s0) = pk8(o1);
#pragma unroll
                    for (int t = 0; t < 8; ++t) *(LAS unsigned*)(Bn + (s0 + t) * CN_LD + n) = pk2(o0[t], o1[t]);
                } else {
                    const int n = c0 - 384;
#pragma unroll
                    for (int t = 0; t < 8; ++t) *(LAS unsigned*)(Cn + (s0 + t) * CN_LD + n) = pk2(o0[t], o1[t]);
                }
            }
        }
        u32x4 zq[4];
#pragma unroll
        for (int k = 0; k < 4; ++k) zq[k] = *(const u32x4*)(ZY + (size_t)(rowc + zr) * 2048 + 256 * g + 8 * (zc + 8 * k));
        SSD_BAR();
        SSD_PREFETCH(c + 1 < nch ? c + 1 : c);
        __builtin_amdgcn_sched_barrier(0);
        {
            const int lt = wid >> 1, st2 = (wid & 1) * 2;
            f32x4 cb0 = (f32x4){0.f, 0.f, 0.f, 0.f}, cb1 = cb0;
#pragma unroll
            for (int kk = 0; kk < 4; ++kk) {
                const bf16x8 av = *(const LAS bf16x8*)(Cn + (16 * lt + r) * CN_LD + 32 * kk + 8 * q);
                const bf16x8 b0 = *(const LAS bf16x8*)(Bn + (16 * st2 + r) * CN_LD + 32 * kk + 8 * q);
                const bf16x8 b1 = *(const LAS bf16x8*)(Bn + (16 * (st2 + 1) + r) * CN_LD + 32 * kk + 8 * q);
                cb0 = MFMA16(av, b0, cb0); cb1 = MFMA16(av, b1, cb1);
            }
#pragma unroll
            for (int i = 0; i < 4; ++i) { CB[(16 * lt + 4 * q + i) * CB_LD + 16 * st2 + r] = cb0[i]; CB[(16 * lt + 4 * q + i) * CB_LD + 16 * (st2 + 1) + r] = cb1[i]; }
        }
        f32x4 y[4][2];
#pragma unroll
        for (int lt = 0; lt < 4; ++lt) { y[lt][0] = (f32x4){0.f, 0.f, 0.f, 0.f}; y[lt][1] = y[lt][0]; }
#pragma unroll
        for (int kk = 0; kk < 4; ++kk) {
            bf16x8 hf[2];
#pragma unroll
            for (int pt = 0; pt < 2; ++pt) { float t8[8];
#pragma unroll
                for (int i = 0; i < 4; ++i) { t8[i] = st[2 * kk][pt][i]; t8[4 + i] = st[2 * kk + 1][pt][i]; }
                hf[pt] = pk8(t8); }
#pragma unroll
            for (int lt = 0; lt < 4; ++lt) {
                const s16x4 lo = *(const LAS s16x4*)(Cn + (16 * lt + r) * CN_LD + 32 * kk + 4 * q);
                const s16x4 hi = *(const LAS s16x4*)(Cn + (16 * lt + r) * CN_LD + 32 * kk + 16 + 4 * q);
                const bf16x8 av = __builtin_shufflevector(lo, hi, 0, 1, 2, 3, 4, 5, 6, 7);
                y[lt][0] = MFMA16(av, hf[0], y[lt][0]); y[lt][1] = MFMA16(av, hf[1], y[lt][1]);
            }
        }
#pragma unroll
        for (int lt = 0; lt < 4; ++lt) { const f32x4 ac = *(const LAS f32x4*)(AC + j * 64 + 16 * lt + 4 * q);
#pragma unroll
            for (int i = 0; i < 4; ++i) { const float e = __expf(ac[i]); y[lt][0][i] *= e; y[lt][1][i] *= e; } }
#pragma unroll
        for (int k = 0; k < 4; ++k) *(LAS u32x4*)(ZS + zr * ZS_LD + 8 * (zc + 8 * k)) = zq[k];
        SSD_BAR();
        {
            const float aend = AC[j * 64 + 63]; const float cdec = __expf(aend);
#pragma unroll
            for (int nt = 0; nt < 8; ++nt) { st[nt][0] *= cdec; st[nt][1] *= cdec; }
#pragma unroll
            for (int kk = 0; kk < 2; ++kk) {
                const f32x4 a0 = *(const LAS f32x4*)(AC + j * 64 + 32 * kk + 8 * q), a1 = *(const LAS f32x4*)(AC + j * 64 + 32 * kk + 8 * q + 4);
                const f32x4 d0 = *(const LAS f32x4*)(DTV + j * 64 + 32 * kk + 8 * q), d1 = *(const LAS f32x4*)(DTV + j * 64 + 32 * kk + 8 * q + 4);
                float acs[8], dts[8];
#pragma unroll
                for (int i = 0; i < 4; ++i) { acs[i] = a0[i]; acs[4 + i] = a1[i]; dts[i] = d0[i]; dts[4 + i] = d1[i]; }
                bf16x8 xf[2];
#pragma unroll
                for (int pt = 0; pt < 2; ++pt) xf[pt] = *(const LAS bf16x8*)(Xt + (j * 64 + 32 * hw + 16 * pt + r) * XT_LD + 32 * kk + 8 * q);
#pragma unroll
                for (int lt = 0; lt < 4; ++lt) {
                    if (kk == 1 && lt < 2) continue;
                    const int l = 16 * lt + r; const float al = AC[j * 64 + l];
                    const f32x4 c0v = *(const LAS f32x4*)(CB + l * CB_LD + 32 * kk + 8 * q), c1v = *(const LAS f32x4*)(CB + l * CB_LD + 32 * kk + 8 * q + 4);
                    float gv[8];
#pragma unroll
                    for (int i = 0; i < 8; ++i) { const int s = 32 * kk + 8 * q + i; const float cbv = i < 4 ? c0v[i & 3] : c1v[i & 3];
                        const float gq = cbv * __expf(al - acs[i]) * dts[i];
                        gv[i] = (kk == 0 && lt >= 2) ? gq : (s <= l ? gq : 0.f); }
                    const bf16x8 gf = pk8(gv);
                    y[lt][0] = MFMA16(gf, xf[0], y[lt][0]); y[lt][1] = MFMA16(gf, xf[1], y[lt][1]);
                }
                bf16x8 xs[2];
                float wsc[8];
#pragma unroll
                for (int i = 0; i < 8; ++i) wsc[i] = dts[i] * __expf(aend - acs[i]);
#pragma unroll
                for (int pt = 0; pt < 2; ++pt) { const u32x4 xu = __builtin_bit_cast(u32x4, xf[pt]); float t8[8];
                    t8[0] = bflo(xu.x) * wsc[0]; t8[1] = bfhi(xu.x) * wsc[1]; t8[2] = bflo(xu.y) * wsc[2]; t8[3] = bfhi(xu.y) * wsc[3];
                    t8[4] = bflo(xu.z) * wsc[4]; t8[5] = bfhi(xu.z) * wsc[5]; t8[6] = bflo(xu.w) * wsc[6]; t8[7] = bfhi(xu.w) * wsc[7];
                    xs[pt] = pk8(t8); }
#pragma unroll
                for (int nt = 0; nt < 8; ++nt) { const bf16x8 bf = *(const LAS bf16x8*)(Bt + (16 * nt + r) * BT_LD + 32 * kk + 8 * q);
                    st[nt][0] = MFMA16(bf, xs[0], st[nt][0]); st[nt][1] = MFMA16(bf, xs[1], st[nt][1]); }
            }
        }
        {
            float sq[4][4];
#pragma unroll
            for (int lt = 0; lt < 4; ++lt) {
#pragma unroll
                for (int i = 0; i < 4; ++i) sq[lt][i] = 0.f;
#pragma unroll
                for (int pt = 0; pt < 2; ++pt) {
                    const u32x2 xv = *(const LAS u32x2*)(Xt + (j * 64 + 32 * hw + 16 * pt + r) * XT_LD + 16 * lt + 4 * q);
                    const float xs4[4] = {bflo(xv.x), bfhi(xv.x), bflo(xv.y), bfhi(xv.y)};
#pragma unroll
                    for (int i = 0; i < 4; i += 2) {
                        LAS bf16* zp0 = ZS + (16 * lt + 4 * q + i) * ZS_LD + 64 * j + 32 * hw + 16 * pt + r; LAS bf16* zp1 = zp0 + ZS_LD;
                        const f32x2 zz = (f32x2){bf1(*zp0), bf1(*zp1)};
                        const f32x2 v = ((f32x2){y[lt][pt][i], y[lt][pt][i + 1]} + dsk * (f32x2){xs4[i], xs4[i + 1]}) * silu2(zz);
                        const unsigned vb = pk2(v.x, v.y); *zp0 = (bf16)(vb & 0xffffu); *zp1 = (bf16)(vb >> 16);
                        const f32x2 vr = (f32x2){bflo(vb), bfhi(vb)}; sq[lt][i] += vr.x * vr.x; sq[lt][i + 1] += vr.y * vr.y;
                    }
                }
#pragma unroll
                for (int i = 0; i < 4; ++i) { float s = sq[lt][i]; s += __shfl_xor(s, 1); s += __shfl_xor(s, 2); s += __shfl_xor(s, 4); s += __shfl_xor(s, 8); sq[lt][i] = s; }
                if (r == 0) *(LAS f32x4*)(SQ + wid * 64 + 16 * lt + 4 * q) = (f32x4){sq[lt][0], sq[lt][1], sq[lt][2], sq[lt][3]};
            }
            SSD_BAR();
            float tot = 0.f;
#pragma unroll
            for (int w = 0; w < 8; ++w) tot += SQ[w * 64 + zr];
            const float rs = rsqrtf(tot * (1.f / 256.f) + EPS);
#pragma unroll
            for (int k = 0; k < 4; ++k) { f32x4 v0, v1; pg8::unpack8(*(const LAS u32x4*)(ZS + zr * ZS_LD + 8 * (zc + 8 * k)), v0, v1);
                *(u32x4*)(ZY + (size_t)(rowc + zr) * 2048 + 256 * g + 8 * (zc + 8 * k)) = pg8::pack8(v0 * rs, v1 * rs); }
        }
    }
#undef SSD_PREFETCH
#pragma unroll
    for (int nt = 0; nt < 8; ++nt)
#pragma unroll
        for (int pt = 0; pt < 2; ++pt) *(f32x4*)(o_ss + ((size_t)(sb * 32 + h) * 64 + 32 * hw + 16 * pt + r) * 128 + 16 * nt + 4 * q) = st[nt][pt];
}
}

__device__ __forceinline__ void mixa_phase(const Args& a, int wave, int lane, int bxo, int nb) {
    const int gw = bxo * NWAVES + wave, NGW = nb * NWAVES;
    bf16* AB = (bf16*)(a.ws + WS_AB);
    for (int it0 = gw; it0 < 1056; it0 += NGW) {
        const int it = it0 >> 1, ch = 512 * (it0 & 1) + 8 * lane;
        f32x4 w0[2], w1[2], w2[2];
#pragma unroll
        for (int e = 0; e < 2; ++e) { w0[e] = *(const f32x4*)(a.conv_a_w + ch + 4 * e); w1[e] = *(const f32x4*)(a.conv_a_w + 1024 + ch + 4 * e); w2[e] = *(const f32x4*)(a.conv_a_w + 2048 + ch + 4 * e); }
        const bool samp = it >= 512; const int sb = samp ? it - 512 : it >> 5, c = samp ? 0 : it & 31, nch = samp ? 1 : 32;
        const int row = samp ? M_P + 64 * sb : 2048 * sb + 64 * c;
        const bf16* V = samp ? (const bf16*)(a.ws + WS_VS) - (size_t)M_P * 1024 : (const bf16*)(a.ws + WS_V);
        f32x4 p2[2], p1[2];
        if (c > 0) { pg8::unpack8(*(const u32x4*)(V + (size_t)(row - 2) * 1024 + ch), p2[0], p2[1]); pg8::unpack8(*(const u32x4*)(V + (size_t)(row - 1) * 1024 + ch), p1[0], p1[1]); }
        else if (samp) { const float* hs = a.st_ca + (size_t)sb * 2 * 1024 + ch; p2[0] = *(const f32x4*)hs; p2[1] = *(const f32x4*)(hs + 4); p1[0] = *(const f32x4*)(hs + 1024); p1[1] = *(const f32x4*)(hs + 1028); }
        else { p2[0] = p2[1] = p1[0] = p1[1] = (f32x4){0.f, 0.f, 0.f, 0.f}; }
        float* o_ca = a.out + (samp ? O_CA_S : O_CA_P) + (size_t)sb * 2 * 1024 + ch;
        for (int t0 = 0; t0 < 64; t0 += 8) {
            u32x4 vv[8], aa[8];
#pragma unroll
            for (int k = 0; k < 8; ++k) { vv[k] = *(const u32x4*)(V + (size_t)(row + t0 + k) * 1024 + ch); aa[k] = *(const u32x4*)(AB + (size_t)(row + t0 + k) * 1024 + ch); }
#pragma unroll
            for (int k = 0; k < 8; ++k) { const int t = t0 + k;
                f32x4 v[2], ab[2];
                pg8::unpack8(vv[k], v[0], v[1]); pg8::unpack8(aa[k], ab[0], ab[1]);
                const f32x4 u0 = ab[0] * (w0[0] * p2[0] + w1[0] * p1[0] + w2[0] * v[0]), u1 = ab[1] * (w0[1] * p2[1] + w1[1] * p1[1] + w2[1] * v[1]);
                *(u32x4*)(AB + (size_t)(row + t) * 1024 + ch) = pg8::pack8(u0, u1);
                if (c == nch - 1 && t >= 62) { *(f32x4*)(o_ca + (t - 62) * 1024) = v[0]; *(f32x4*)(o_ca + (t - 62) * 1024 + 4) = v[1]; }
                p2[0] = p1[0]; p2[1] = p1[1]; p1[0] = v[0]; p1[1] = v[1]; }
        }
    }
}

template <bool FIRST> __device__ __forceinline__ void row_phase(const Args& a, const bf16* Y, const float* SCR, int nsl, const float* SSQ, const float* wpost, bf16* HX, const float* RX, float* RH, int wave, int lane) {
    const int gw = blockIdx.x * NWAVES + wave, NGW = gridDim.x * NWAVES;
    f32x4 wp[2][2], wq[2][2];
#pragma unroll
    for (int j = 0; j < 2; ++j)
#pragma unroll
        for (int e = 0; e < 2; ++e) { wp[j][e] = *(const f32x4*)(wpost + 8 * lane + 512 * j + 4 * e); if (FIRST) { const f32x4 w = *(const f32x4*)(a.n_mix_pre + 8 * lane + 512 * j + 4 * e); wq[j][e] = (f32x4){1.f / w[0], 1.f / w[1], 1.f / w[2], 1.f / w[3]}; } }
    for (int m0 = gw; m0 < M; m0 += 2 * NGW) {
        const int mm[2] = {m0, m0 + NGW < M ? m0 + NGW : m0};
        f32x4 yq[2][2][2]; f32x4 bq[2][2][2]; float sq[2];
#pragma unroll
        for (int rr = 0; rr < 2; ++rr) { const int m = mm[rr];
            if (m < M_P) { sq[rr] = SSQ[m];
#pragma unroll
                for (int j = 0; j < 2; ++j) pg8::unpack8(*(const u32x4*)(Y + (size_t)m * DM + 8 * lane + 512 * j), yq[rr][j][0], yq[rr][j][1]);
            } else {
                const float* sr = SCR + (size_t)(m - M_P) * DM; float s = 0.f;
#pragma unroll
                for (int j = 0; j < 2; ++j)
#pragma unroll
                    for (int e = 0; e < 2; ++e) yq[rr][j][e] = (f32x4){0.f, 0.f, 0.f, 0.f};
                for (int sl = 0; sl < nsl; ++sl)
#pragma unroll
                    for (int j = 0; j < 2; ++j)
#pragma unroll
                        for (int e = 0; e < 2; ++e) yq[rr][j][e] += *(const f32x4*)(sr + (size_t)sl * 1024 * 1024 + 8 * lane + 512 * j + 4 * e);
#pragma unroll
                for (int j = 0; j < 2; ++j)
#pragma unroll
                    for (int e = 0; e < 2; ++e) { const f32x4 t = yq[rr][j][e]; s += (t[0] * t[0] + t[1] * t[1]) + (t[2] * t[2] + t[3] * t[3]); }
                sq[rr] = wave_sum(s);
            }
#pragma unroll
            for (int j = 0; j < 2; ++j) pg8::unpack8(*(const u32x4*)(HX + (size_t)m * DM + 8 * lane + 512 * j), bq[rr][j][0], bq[rr][j][1]);
            if (FIRST) { const float rinv = 1.f / RX[m];
#pragma unroll
                for (int j = 0; j < 2; ++j) { bq[rr][j][0] = bq[rr][j][0] * rinv * wq[j][0]; bq[rr][j][1] = bq[rr][j][1] * rinv * wq[j][1]; } } }
#pragma unroll
        for (int rr = 0; rr < 2; ++rr) { const int m = mm[rr];
            const float rs = rsqrtf(sq[rr] * (1.f / DM) + EPS);
            f32x4 hv[2][2]; float s2 = 0.f;
#pragma unroll
            for (int j = 0; j < 2; ++j) {
                const f32x4 y0 = yq[rr][j][0], y1 = yq[rr][j][1];
                hv[j][0] = bq[rr][j][0] + y0 * rs * wp[j][0];
                hv[j][1] = bq[rr][j][1] + y1 * rs * wp[j][1];
#pragma unroll
                for (int e = 0; e < 2; ++e) s2 += (hv[j][e][0] * hv[j][e][0] + hv[j][e][1] * hv[j][e][1]) + (hv[j][e][2] * hv[j][e][2] + hv[j][e][3] * hv[j][e][3]);
                if (FIRST) *(u32x4*)(HX + (size_t)m * DM + 8 * lane + 512 * j) = pg8::pack8(hv[j][0], hv[j][1]);
                else { __builtin_nontemporal_store(hv[j][0], (f32x4*)(a.out + (size_t)m * DM + 8 * lane + 512 * j)); __builtin_nontemporal_store(hv[j][1], (f32x4*)(a.out + (size_t)m * DM + 8 * lane + 512 * j + 4)); }
            }
            if (FIRST) { const float rh = rsqrtf(wave_sum(s2) * (1.f / DM) + EPS); if (lane == 0) RH[m] = rh; }
        }
    }
}

#define XB_TMO      128
#define XB_XCNT(j)  (256  + 64 * (j))
#define XB_XSUB(j)  (1280 + 64 * (j))
#define XB_XGEN(j)  (2304 + 64 * (j))
#define XB_TOP      3328
#define XB_TOPGEN   3392
#define XCD_BAR_WORDS 3456
#define XB_SPIN_CAP (1u << 18)

__device__ __forceinline__ unsigned xb_ld(unsigned* p)              { return __hip_atomic_load(p, __ATOMIC_RELAXED, __HIP_MEMORY_SCOPE_AGENT); }
__device__ __forceinline__ unsigned xb_add(unsigned* p, unsigned v) { return __hip_atomic_fetch_add(p, v, __ATOMIC_RELAXED, __HIP_MEMORY_SCOPE_AGENT); }
__device__ __forceinline__ unsigned xb_xcc_id() { return (unsigned)__builtin_amdgcn_s_getreg((3 << 11) | 20) & 0xFu; }
#define XB_SPIN(cond, bar) do { unsigned _sp = 0; while (cond) { __builtin_amdgcn_s_sleep(1); \
    if ((++_sp & 255u) == 0u) { if (xb_ld(&(bar)[XB_TMO])) break; if (_sp > XB_SPIN_CAP) { atomicAdd(&(bar)[XB_TMO], 1u); break; } } } } while (0)

struct XcdBarrier {
    unsigned* bar; unsigned x;
    volatile LAS unsigned* st;
};

__device__ __forceinline__ XcdBarrier xcd_barrier_post(unsigned* bar, volatile LAS unsigned* st) {
    XcdBarrier b; b.bar = bar; b.x = xb_xcc_id(); b.st = st;
    if (threadIdx.x == 0) (void)xb_add(&bar[XB_XCNT(b.x)], 1u);
    return b;
}
__device__ __forceinline__ void xcd_barrier_complete(unsigned* bar, unsigned x, unsigned& nloc, unsigned& nx) {
    const unsigned G = gridDim.x * gridDim.y * gridDim.z;
    unsigned sum, cnt, mine, sp = 0u;
    for (;;) {
        sum = 0u; cnt = 0u; mine = 0u;
#pragma unroll
        for (unsigned j = 0; j < 16; ++j) { const unsigned c = xb_ld(&bar[XB_XCNT(j)]); sum += c; cnt += (c > 0u) ? 1u : 0u; mine = (j == x) ? c : mine; }
        if (sum == G) break;
        __builtin_amdgcn_s_sleep(1);
        if ((++sp & 255u) == 0u) { if (xb_ld(&bar[XB_TMO])) break; if (sp > XB_SPIN_CAP) { atomicAdd(&bar[XB_TMO], 1u); break; } }
    }
    nloc = mine > 0u ? mine : 1u; nx = cnt > 0u ? cnt : 1u;
}

__device__ __forceinline__ void xcd_barrier(const XcdBarrier& b) {
    asm volatile("s_waitcnt vmcnt(0)" ::: "memory");
    __syncthreads();
    if (threadIdx.x == 0) {
        unsigned* bar = b.bar;
        __builtin_amdgcn_s_waitcnt(0);
        unsigned nloc = b.st[0], nx = b.st[1];
        if (nloc == 0u) { xcd_barrier_complete(bar, b.x, nloc, nx); b.st[0] = nloc; b.st[1] = nx; }
        const unsigned old = xb_add(&bar[XB_XSUB(b.x)], 1u);
        const unsigned gen = old / nloc;
        if (old + 1u == (gen + 1u) * nloc) {
            __builtin_amdgcn_fence(__ATOMIC_RELEASE, "agent");
            asm volatile("s_waitcnt vmcnt(0)" ::: "memory");
            const unsigned og = xb_add(&bar[XB_TOP], 1u);
            const unsigned tg = og / nx;
            if (og + 1u == (tg + 1u) * nx) xb_add(&bar[XB_TOPGEN], 1u);
            else XB_SPIN(xb_ld(&bar[XB_TOPGEN]) == tg, bar);
            __builtin_amdgcn_fence(__ATOMIC_ACQUIRE, "agent");
            xb_add(&bar[XB_XGEN(b.x)], 1u);
            asm volatile("s_waitcnt vmcnt(0)" ::: "memory");
        } else {
            XB_SPIN(xb_ld(&bar[XB_XGEN(b.x)]) == gen, bar);
            __builtin_amdgcn_fence(__ATOMIC_ACQUIRE, "agent");
            asm volatile("s_waitcnt vmcnt(0)" ::: "memory");
        }
    }
    __syncthreads();
}

__global__ void __launch_bounds__(NWAVES * 64, 2) mega_fwd(Args a) {
    extern __shared__ __attribute__((aligned(16))) unsigned char lds_raw[];
    LAS unsigned char* lds = (LAS unsigned char*)lds_raw;
    cg::grid_group grid = cg::this_grid();
    int tid = threadIdx.x, lane, wave;
#define FRESH_TID() do { tid = threadIdx.x; asm volatile("" : "+v"(tid)); lane = tid & 63; wave = __builtin_amdgcn_readfirstlane(tid >> 6); } while (0)
    FRESH_TID();
    const int G = gridDim.x, bx = blockIdx.x;
    unsigned char* ws = a.ws;
    bf16* ZY = (bf16*)a.out;
    volatile LAS unsigned* bst = (volatile LAS unsigned*)(lds + LDS_BYTES - 64);
    if (tid == 0) { bst[0] = 0u; bst[1] = 0u; }
    __syncthreads();
    const XcdBarrier bar = xcd_barrier_post((unsigned*)(ws + WS_BAR), bst);
#define GRID_BAR() xcd_barrier(bar)
    if (a.coop_sync) grid.sync();
    p0_prologue(a, lds, wave, lane);
    GRID_BAR();
    { pg8::Gemm g{(const bf16*)(ws + WS_XN), (const bf16*)(ws + WS_WINA), M, N1A, 1024, 1024}; pg8::StaticOrder S; S.init(M, N1A, G, bx);
      pg8::EpiP1a E{ZY, (bf16*)(ws + WS_XBC), (float*)(ws + WS_DT)};
      pg8::gemm_phase<pg8::EpiP1a, pg8::StaticOrder, true, true>(lds, g, S, E); }
    GRID_BAR();
    { const int NS = G / 2;
      if (bx >= NS) { pg8::Gemm g{(const bf16*)(ws + WS_XN), (const bf16*)(ws + WS_WINB), M, 2048, 1024, 1024}; pg8::StaticOrder S; S.init(M, 2048, G - NS, bx - NS);
             pg8::EpiP2g E{(bf16*)(ws + WS_AB), (bf16*)(ws + WS_GA), a.b_gate};
             pg8::gemm_phase<pg8::EpiP2g, pg8::StaticOrder, true, true>(lds, g, S, E);
             const int c2 = (bx - NS) >= 32 ? (bx - NS) - 32 : (bx - NS) + (G - NS) - 32;
             pg8::Gemm g2{(const bf16*)(ws + WS_XN) + (size_t)M_P * 1024, (const bf16*)(ws + WS_WINB) + (size_t)2048 * 1024, M_S, 3072, 1024, 1024}; pg8::StaticOrder S2; S2.init(M_S, 3072, G - NS, c2);
             pg8::EpiP1b E2{(bf16*)(ws + WS_VS) - (size_t)M_P * 1024, (bf16*)(ws + WS_GBS) - (size_t)M_P * 1024, a.b_gate, 128};
             pg8::gemm_phase<pg8::EpiP1b, pg8::StaticOrder, true, true>(lds, g2, S2, E2); }
      for (int u = bx; u < 256; u += G) { ssd::unit(a, lds, u >> 3, u & 7); __syncthreads(); }
      if (G < 256) for (int u = G + bx; u < 256; u += G) { ssd::unit(a, lds, u >> 3, u & 7); __syncthreads(); } }
    GRID_BAR();
    { pg8::Gemm g{(const bf16*)(ws + WS_XN), (const bf16*)(ws + WS_WINB) + (size_t)2048 * 1024, M_P, 3072, 1024, 1024}; pg8::StaticOrder S; S.init(M_P, 3072, G, bx);
      pg8::EpiP1b E{(bf16*)(ws + WS_V), (bf16*)(ws + WS_GB), a.b_gate, 0};
      pg8::gemm_phase<pg8::EpiP1b, pg8::StaticOrder, true, true>(lds, g, S, E); }
    GRID_BAR();
    { pg8::Gemm g{(const bf16*)ZY, (const bf16*)(ws + WS_WB), M, 1024, 2048, 2048}; pg8::StaticOrder S; S.init(M, 1024, G, bx);
      pg8::EpiGate<0> E{(bf16*)(ws + WS_MG), (const bf16*)(ws + WS_GB), (const bf16*)(ws + WS_GBS) - (size_t)M_P * 1024};
      pg8::gemm_phase<pg8::EpiGate<0>, pg8::StaticOrder, true, true>(lds, g, S, E); }
    { const int ntail = (G == 256) ? 16 : 0;
      FRESH_TID(); if (bx >= ntail) mixa_phase(a, wave, lane, bx - ntail, G - ntail); }
    GRID_BAR();
    { pg8::Gemm g{(const bf16*)(ws + WS_AB), (const bf16*)(ws + WS_WA), M, 1024, 1024, 1024}; pg8::StaticOrder S; S.init(M, 1024, G, bx);
      pg8::EpiGate<1> E{(bf16*)(ws + WS_MG), (const bf16*)(ws + WS_GA), (const bf16*)(ws + WS_GA)};
      pg8::gemm_phase<pg8::EpiGate<1>, pg8::StaticOrder, true, true>(lds, g, S, E); }
    { const int ntail = (G == 256) ? 16 : 0;
      FRESH_TID(); if (bx >= ntail) convert_items(a, lds, wave, lane, (bx - ntail) * NWAVES + wave, (G - ntail) * NWAVES, CV_EARLY, CV_ALL); }
    GRID_BAR();
    { pg8::Gemm g{(const bf16*)(ws + WS_MG), (const bf16*)(ws + WS_WO), M, 1024, 1024, 1024}; pg8::StaticOrder S; S.init(M_P, 1024, G, bx);
      pg8::EpiSsq E{(bf16*)(ws + WS_MO), (float*)(ws + WS_SSQ1)};
      pg8::gemm_phase<pg8::EpiSsq, pg8::StaticOrder, true, true>(lds, g, S, E); }
    { pg8::Gemm g{(const bf16*)(ws + WS_MG), (const bf16*)(ws + WS_WO), M, 1024, 1024, 128}; pg8::TailOrder S{G, bx, 8, 128 * 2};
      pg8::EpiPartial E{(float*)(ws + WS_SCR), 128 * 2};
      pg8::gemm_phase<pg8::EpiPartial, pg8::TailOrder, true, true>(lds, g, S, E); }
    GRID_BAR();
    FRESH_TID(); row_phase<true>(a, (const bf16*)(ws + WS_MO), (const float*)(ws + WS_SCR), 8, (const float*)(ws + WS_SSQ1), a.n_mix_post, (bf16*)(ws + WS_XN), (const float*)(ws + WS_RX), (float*)(ws + WS_RH), wave, lane);
    GRID_BAR();
    { pg8::Gemm g{(const bf16*)(ws + WS_XN), (const bf16*)(ws + WS_W1), M, FF, 1024, 1024}; pg8::StaticOrder S; S.init(M, FF, G, bx);
      pg8::EpiRelu2 E{(bf16*)(ws + WS_F), (const float*)(ws + WS_RH)};
      pg8::gemm_phase<pg8::EpiRelu2, pg8::StaticOrder, true, true>(lds, g, S, E); }
    GRID_BAR();
    { pg8::Gemm g{(const bf16*)(ws + WS_F), (const bf16*)(ws + WS_W2), M, 1024, FF, FF}; pg8::StaticOrder S; S.init(M_P, 1024, G, bx, 1);
      pg8::EpiSsq E{(bf16*)(ws + WS_F2), (float*)(ws + WS_SSQ2)};
      pg8::gemm_phase<pg8::EpiSsq, pg8::StaticOrder, true, true>(lds, g, S, E); }
    { pg8::Gemm g{(const bf16*)(ws + WS_F), (const bf16*)(ws + WS_W2), M, 1024, FF, 256}; pg8::TailOrder S{G, bx, 16, 256 * 2};
      pg8::EpiPartial E{(float*)(ws + WS_SCR), 256 * 2};
      pg8::gemm_phase<pg8::EpiPartial, pg8::TailOrder, true, true>(lds, g, S, E); }
    GRID_BAR();
    FRESH_TID(); row_phase<false>(a, (const bf16*)(ws + WS_F2), (const float*)(ws + WS_SCR), 16, (const float*)(ws + WS_SSQ2), a.n_ffn_post, (bf16*)(ws + WS_XN), nullptr, nullptr, wave, lane);
}

extern "C" void kernel_launch(void* const* d_in, const int* in_sizes, int n_in, void* d_out, int out_size, void* d_ws, size_t ws_size, hipStream_t stream) {
    static int grid = 0;
    if (grid == 0) {
        if (n_in != 23 || ws_size < WS_END) { fprintf(stderr, "kernel_launch: unexpected n_in %d / ws_size %zu (need %zu)\n", n_in, ws_size, (size_t)WS_END); grid = -1; return; }
        int dev = 0, cus = 0, per_cu = 0;
        hipGetDevice(&dev); hipDeviceGetAttribute(&cus, hipDeviceAttributeMultiprocessorCount, dev);
        if (hipFuncSetAttribute((const void*)mega_fwd, hipFuncAttributeMaxDynamicSharedMemorySize, LDS_BYTES) != hipSuccess) { fprintf(stderr, "kernel_launch: hipFuncSetAttribute failed\n"); grid = -1; return; }
        if (hipOccupancyMaxActiveBlocksPerMultiprocessor(&per_cu, (const void*)mega_fwd, NWAVES * 64, LDS_BYTES) != hipSuccess || per_cu < 1) { fprintf(stderr, "kernel_launch: occupancy query says %d\n", per_cu); per_cu = 1; }
        (void)hipGetLastError();
        grid = cus * 1;
    }
    if (grid < 0) return;
    Args a{};
    const float** f = (const float**)&a;
    for (int i = 0; i < 23; ++i) f[i] = (const float*)d_in[i];
    a.out = (float*)d_out; a.ws = (unsigned char*)d_ws;
    if (hipMemsetAsync((char*)d_ws + WS_BAR, 0, XCD_BAR_WORDS * 4, stream) != hipSuccess) { fprintf(stderr, "kernel_launch: hipMemsetAsync of the barrier words failed\n"); return; }
    void* args[] = {&a};
    hipError_t e = hipLaunchCooperativeKernel((const void*)mega_fwd, dim3(grid), dim3(NWAVES * 64), args, LDS_BYTES, stream);
    if (e != hipSuccess) fprintf(stderr, "kernel_launch: cooperative launch failed: %s (grid %d)\n", hipGetErrorString(e), grid);
}
```

```cpp
#include <hip/hip_runtime.h>
#include <hip/hip_cooperative_groups.h>
#include <cstdio>
#include <cstdint>
namespace cg = cooperative_groups;
namespace pg8 {
#define PG8_LAS __attribute__((address_space(3)))
typedef unsigned short bf16_t;
typedef short bf16x8 __attribute__((ext_vector_type(8)));
typedef float f32x4 __attribute__((ext_vector_type(4)));
typedef unsigned u32x4 __attribute__((ext_vector_type(4)));
constexpr int BM = 256, BK = 64, HALF = 128, HTB = HALF * BK * 2  , STAGE_BYTES = 8 * HTB, NXCD = 8, WGM = 8;

__host__ __device__ __forceinline__ int lds_byte(int r, int c) { const int st = (r >> 4) * 2 + (c >> 5), rr = r & 15, cc = c & 31, ob = rr * 64 + cc * 2; return st * 1024 + (ob ^ (((ob >> 9) & 1) << 5)); }
__host__ __device__ __forceinline__ void stage_rc(int b, int& R, int& C) { const int st = b / 1024, sb = b % 1024, swz = sb ^ (((sb >> 9) & 1) << 5); R = (st >> 1) * 16 + swz / 64; C = (st & 1) * 32 + (swz % 64) / 2; }
__host__ __device__ __forceinline__ int perm32(int rho) { const int n = rho >> 4, i = rho & 15; return 8 * (i >> 2) + 4 * n + (i & 3); }

struct Unit { int pm, pn, kb; };
struct Gemm { const bf16_t* A; const bf16_t* Bt; int M, N, K, KL; };

struct StaticOrder {
    int nM, nN, nwg, G, c;
    __host__ __device__ void init(int M, int N, int G_, int c_) { nM = M / BM; nN = N / BM; nwg = nM * nN; G = G_; c = c_; }
    __host__ __device__ bool next(int i, Unit& u) const {
        const long L = (long)i * G + c; if (L >= nwg || c < 0) return false;
        int wgid = (int)L; { const int q = nwg / NXCD, r = nwg % NXCD, xcd = wgid % NXCD, off = wgid / NXCD; wgid = (xcd < r ? xcd * (q + 1) : r * (q + 1) + (xcd - r) * q) + off; }
        const int nig = WGM * nN, gid = wgid / nig, fm = gid * WGM, gsz = (nM - fm) < WGM ? (nM - fm) : WGM;
        u.pm = fm + ((wgid % nig) % gsz); u.pn = (wgid % nig) / gsz; u.kb = 0; return true;
    }
    __device__ __forceinline__ void a_ready(const Unit&) const {}
    __device__ __forceinline__ void done(const Unit&) const {}
};

__device__ __forceinline__ unsigned cvt_pk_bf16(float lo, float hi) { unsigned r; asm volatile("v_cvt_pk_bf16_f32 %0, %1, %2" : "=v"(r) : "v"(lo), "v"(hi)); return r; }
__device__ __forceinline__ u32x4 pack8(f32x4 v0, f32x4 v1) { u32x4 w; w.x = cvt_pk_bf16(v0[0], v0[1]); w.y = cvt_pk_bf16(v0[2], v0[3]); w.z = cvt_pk_bf16(v1[0], v1[1]); w.w = cvt_pk_bf16(v1[2], v1[3]); return w; }
__device__ __forceinline__ float bf_lo(unsigned w) { return __uint_as_float(w << 16); }
__device__ __forceinline__ float bf_hi(unsigned w) { return __uint_as_float(w & 0xffff0000u); }
__device__ __forceinline__ void unpack8(u32x4 w, f32x4& v0, f32x4& v1) { v0 = (f32x4){bf_lo(w.x), bf_hi(w.x), bf_lo(w.y), bf_hi(w.y)}; v1 = (f32x4){bf_lo(w.z), bf_hi(w.z), bf_lo(w.w), bf_hi(w.w)}; }
__device__ __forceinline__ float sigm(float v) { return 1.0f / (1.0f + __expf(-v)); }

#define EPI_LOOP_AM _Pragma("unroll") for (int ai = 0; ai < 2; ++ai) _Pragma("unroll") for (int m = 0; m < 4; ++m)

struct EpiP1a {
    static constexpr bool PERM = true, AFTER_DRAIN = false;
    bf16_t* Z; bf16_t* XBC; float* DT;
    __device__ __forceinline__ void operator()(const f32x4 (&acc)[2][2][4][2], const Unit& u, int wr, int wc, int fr, int fq) const {
        const int row0 = u.pm * BM + wr * 64 + fr, col0 = wc * 32 + 8 * fq;
        if (u.pn < 24) {
            bf16_t* base; int ldc;
            if (u.pn < 8) { base = Z + u.pn * 256; ldc = 2048; } else { base = XBC + (u.pn - 8) * 256; ldc = 4096; }
            EPI_LOOP_AM { bf16_t* rowp = base + (size_t)(row0 + ai * HALF + m * 16) * ldc + col0;
#pragma unroll
                for (int bj = 0; bj < 2; ++bj) *(u32x4*)(rowp + bj * HALF) = pack8(acc[ai][bj][m][0], acc[ai][bj][m][1]); }
        } else if (wc == 0) {
            EPI_LOOP_AM { float* rowp = DT + (size_t)(row0 + ai * HALF + m * 16) * 32 + 8 * fq; *(f32x4*)rowp = acc[ai][0][m][0]; *(f32x4*)(rowp + 4) = acc[ai][0][m][1]; }
        }
    }
};
__device__ __forceinline__ void epi_gate_store(const f32x4 (&acc)[2][2][4][2], bf16_t* GT, const float* bias, int pt, int row0, int col0) {
    const int gc = pt * 256 + col0; bf16_t* base = GT + gc;
    f32x4 bv[2][2];
#pragma unroll
    for (int bj = 0; bj < 2; ++bj)
#pragma unroll
        for (int n = 0; n < 2; ++n) bv[bj][n] = *(const f32x4*)(bias + gc + bj * HALF + 4 * n);
    EPI_LOOP_AM { bf16_t* rowp = base + (size_t)(row0 + ai * HALF + m * 16) * 1024;
#pragma unroll
        for (int bj = 0; bj < 2; ++bj) { f32x4 v0 = acc[ai][bj][m][0] + bv[bj][0], v1 = acc[ai][bj][m][1] + bv[bj][1];
#pragma unroll
            for (int e = 0; e < 4; ++e) { v0[e] = sigm(v0[e]); v1[e] = sigm(v1[e]); }
            *(u32x4*)(rowp + bj * HALF) = pack8(v0, v1); } }
}
struct EpiP2g {
    static constexpr bool PERM = true, AFTER_DRAIN = false;
    bf16_t* AB; bf16_t* GA; const float* bgate;
    __device__ __forceinline__ void operator()(const f32x4 (&acc)[2][2][4][2], const Unit& u, int wr, int wc, int fr, int fq) const {
        const int row0 = u.pm * BM + wr * 64 + fr, col0 = wc * 32 + 8 * fq;
        if (u.pn < 4) {
            bf16_t* base = AB + u.pn * 256;
            EPI_LOOP_AM { bf16_t* rowp = base + (size_t)(row0 + ai * HALF + m * 16) * 1024 + col0;
#pragma unroll
                for (int bj = 0; bj < 2; ++bj) *(u32x4*)(rowp + bj * HALF) = pack8(acc[ai][bj][m][0], acc[ai][bj][m][1]); }
        } else epi_gate_store(acc, GA, bgate, u.pn - 4, row0, col0);
    }
};
struct EpiP1b {
    static constexpr bool PERM = true, AFTER_DRAIN = false;
    bf16_t* V; bf16_t* GB; const float* bgate; int pmo;
    __device__ __forceinline__ void operator()(const f32x4 (&acc)[2][2][4][2], const Unit& u, int wr, int wc, int fr, int fq) const {
        const int row0 = (u.pm + pmo) * BM + wr * 64 + fr, col0 = wc * 32 + 8 * fq;
        if (u.pn < 8) {
            bf16_t* base = V + u.pn * 128;
            EPI_LOOP_AM { bf16_t* rowp = base + (size_t)(row0 + ai * HALF + m * 16) * 1024 + col0;
                *(u32x4*)rowp = pack8(acc[ai][0][m][0] * acc[ai][1][m][0], acc[ai][0][m][1] * acc[ai][1][m][1]); }
        } else epi_gate_store(acc, GB, bgate + 1024, u.pn - 8, row0, col0);
    }
};
template <int MODE> struct EpiGate {
    static constexpr bool PERM = true, AFTER_DRAIN = false;
    bf16_t* O; const bf16_t* Gp; const bf16_t* Gs;
    __device__ __forceinline__ void operator()(const f32x4 (&acc)[2][2][4][2], const Unit& u, int wr, int wc, int fr, int fq) const {
        const int row0 = u.pm * BM + wr * 64 + fr, col0 = u.pn * BM + wc * 32 + 8 * fq;
        const bf16_t* G = u.pm < 128 ? Gp : Gs;
#pragma unroll
        for (int ai = 0; ai < 2; ++ai) {
            u32x4 gq[4][2], oq[4][2];
#pragma unroll
            for (int m = 0; m < 4; ++m)
#pragma unroll
                for (int bj = 0; bj < 2; ++bj) { const size_t off = (size_t)(row0 + ai * HALF + m * 16) * 1024 + col0 + bj * HALF;
                    gq[m][bj] = *(const u32x4*)(G + off); if (MODE == 1) oq[m][bj] = *(const u32x4*)(O + off); }
#pragma unroll
            for (int m = 0; m < 4; ++m)
#pragma unroll
                for (int bj = 0; bj < 2; ++bj) { const size_t off = (size_t)(row0 + ai * HALF + m * 16) * 1024 + col0 + bj * HALF;
                    f32x4 g0, g1; unpack8(gq[m][bj], g0, g1);
                    f32x4 v0 = g0 * acc[ai][bj][m][0], v1 = g1 * acc[ai][bj][m][1];
                    if (MODE == 1) { f32x4 o0, o1; unpack8(oq[m][bj], o0, o1); v0 += o0; v1 += o1; }
                    *(u32x4*)(O + off) = pack8(v0, v1); }
        }
    }
};
struct EpiSsq {
    static constexpr bool PERM = true, AFTER_DRAIN = false;
    bf16_t* O; float* SSQ;
    __device__ __forceinline__ void operator()(const f32x4 (&acc)[2][2][4][2], const Unit& u, int wr, int wc, int fr, int fq) const {
        const int row0 = u.pm * BM + wr * 64 + fr, col0 = u.pn * BM + wc * 32 + 8 * fq;
        EPI_LOOP_AM { const size_t row = (size_t)(row0 + ai * HALF + m * 16); float s = 0.f;
#pragma unroll
            for (int bj = 0; bj < 2; ++bj) { const f32x4 v0 = acc[ai][bj][m][0], v1 = acc[ai][bj][m][1];
                s += (v0[0] * v0[0] + v0[1] * v0[1]) + (v0[2] * v0[2] + v0[3] * v0[3]) + (v1[0] * v1[0] + v1[1] * v1[1]) + (v1[2] * v1[2] + v1[3] * v1[3]);
                *(u32x4*)(O + row * 1024 + col0 + bj * HALF) = pack8(v0, v1); }
            s += __shfl_xor(s, 16); s += __shfl_xor(s, 32);
            if (fq == 0) atomicAdd(SSQ + row, s); }
    }
};
struct TailOrder {
    int G, c, NS, kbytes;
    __host__ __device__ bool next(int i, Unit& u) const {
        const int L = i * G + c; if (L >= 16 * NS) return false;
        const int un = L / NS, ks = L % NS; u.pm = 128 + (un >> 2); u.pn = un & 3; u.kb = ks * kbytes; return true;
    }
    __device__ __forceinline__ void a_ready(const Unit&) const {}
    __device__ __forceinline__ void done(const Unit&) const {}
};
struct EpiPartial {
    static constexpr bool PERM = false, AFTER_DRAIN = false;
    float* SCR; int kbytes;
    __device__ __forceinline__ void operator()(const f32x4 (&acc)[2][2][4][2], const Unit& u, int wr, int wc, int fr, int fq) const {
        const int row0 = (u.pm - 128) * BM + wr * 64 + fr, col0 = u.pn * BM + wc * 32 + 4 * fq;
        float* base = SCR + (size_t)(u.kb / kbytes) * 1024 * 1024;
        EPI_LOOP_AM { float* rowp = base + (size_t)(row0 + ai * HALF + m * 16) * 1024 + col0;
#pragma unroll
            for (int bj = 0; bj < 2; ++bj)
#pragma unroll
                for (int n = 0; n < 2; ++n) *(f32x4*)(rowp + bj * HALF + n * 16) = acc[ai][bj][m][n]; }
    }
};
struct EpiRelu2 {
    static constexpr bool PERM = true, AFTER_DRAIN = false;
    bf16_t* O; const float* RS;
    __device__ __forceinline__ void operator()(const f32x4 (&acc)[2][2][4][2], const Unit& u, int wr, int wc, int fr, int fq) const {
        const int row0 = u.pm * BM + wr * 64 + fr, col0 = u.pn * BM + wc * 32 + 8 * fq;
        float rsv[2][4];
#pragma unroll
        for (int ai = 0; ai < 2; ++ai)
#pragma unroll
            for (int m = 0; m < 4; ++m) rsv[ai][m] = RS[row0 + ai * HALF + m * 16];
        EPI_LOOP_AM { bf16_t* rowp = O + (size_t)(row0 + ai * HALF + m * 16) * 4096 + col0; const float rs = rsv[ai][m];
#pragma unroll
            for (int bj = 0; bj < 2; ++bj) { f32x4 v0 = acc[ai][bj][m][0], v1 = acc[ai][bj][m][1];
#pragma unroll
                for (int e = 0; e < 4; ++e) { const float a = fmaxf(v0[e], 0.f) * rs, b = fmaxf(v1[e], 0.f) * rs; v0[e] = a * a; v1[e] = b * b; }
                *(u32x4*)(rowp + bj * HALF) = pack8(v0, v1); } }
    }
};

template <class Epi, class Sched, bool ALIGN_EPI = false, bool SP2 = false>
__device__ __forceinline__ void gemm_phase(PG8_LAS unsigned char* lds, const Gemm g, const Sched& S, const Epi& E) {
    int tid = threadIdx.x; asm volatile("" : "+v"(tid));
    const int wid = __builtin_amdgcn_readfirstlane(tid >> 6), lane = tid & 63, wr = wid >> 2, wc = wid & 3, fr = lane & 15, fq = lane >> 4;
    const int K = g.K, nt = g.KL / BK;
    unsigned voffA[2], voffB[2];
#pragma unroll
    for (int i = 0; i < 2; ++i) { int R, C; stage_rc(tid * 16 + i * 8192, R, C); const int Rb = Epi::PERM ? ((R & ~31) + perm32(R & 31)) : R;
        voffA[i] = (unsigned)(R * K + C) * 2u; voffB[i] = (unsigned)(Rb * K + C) * 2u; }
    const size_t kstep = (size_t)(BK * 2);
    const size_t hstep = (size_t)HALF * K * 2;
    const size_t tstep = 2 * hstep;
    const unsigned ldsw = (unsigned)wid * 1024u;
    const int aoff = lds_byte(wr * 64 + fr, fq * 8), boff = lds_byte(wc * 32 + fr, fq * 8);
#define PG8_SA(b, h) (((b) * 2 + (h)) * HTB)
#define PG8_SB(b, h) ((4 + (b) * 2 + (h)) * HTB)
#define PG8_STAGE(bufoff, gbase, voff) do { _Pragma("unroll") for (int _i = 0; _i < 2; ++_i) \
        __builtin_amdgcn_global_load_lds((const unsigned*)((const char*)(gbase) + (voff)[_i]), (PG8_LAS unsigned*)(lds + (bufoff) + ldsw + _i * 8192), 16, 0, 0); } while (0)
#define PG8_LDA(dst, b, h) do { _Pragma("unroll") for (int m = 0; m < 4; ++m) _Pragma("unroll") for (int k = 0; k < 2; ++k) dst[m][k] = *(const PG8_LAS bf16x8*)(lds + PG8_SA(b, h) + aoff + m * 2048 + k * 1024); } while (0)
#define PG8_LDB(dst, b, h) do { _Pragma("unroll") for (int n = 0; n < 2; ++n) _Pragma("unroll") for (int k = 0; k < 2; ++k) dst[n][k] = *(const PG8_LAS bf16x8*)(lds + PG8_SB(b, h) + boff + n * 2048 + k * 1024); } while (0)
#define PG8_MMA(ai, bj, At, Bt) do { __builtin_amdgcn_s_setprio(1); _Pragma("unroll") for (int m = 0; m < 4; ++m) _Pragma("unroll") for (int n = 0; n < 2; ++n) _Pragma("unroll") for (int k = 0; k < 2; ++k) \
        acc[ai][bj][m][n] = __builtin_amdgcn_mfma_f32_16x16x32_bf16(Bt[n][k], At[m][k], acc[ai][bj][m][n], 0, 0, 0); __builtin_amdgcn_s_setprio(0); } while (0)
#define PG8_WAIT_V(n) asm volatile("s_waitcnt vmcnt(" #n ")" ::: "memory")
#define PG8_WAIT_L(n) asm volatile("s_waitcnt lgkmcnt(" #n ")" ::: "memory")
#define PG8_BAR __builtin_amdgcn_s_barrier()
#define PG8_SCHED __builtin_amdgcn_sched_barrier(0)
    Unit cur, nxt; int ui = 0;
    if (!S.next(0, cur)) return;
    f32x4 acc[2][2][4][2];
#pragma unroll
    for (int a = 0; a < 2; ++a)
#pragma unroll
        for (int b = 0; b < 2; ++b)
#pragma unroll
            for (int m = 0; m < 4; ++m)
#pragma unroll
                for (int n = 0; n < 2; ++n) acc[a][b][m][n] = (f32x4){0.f, 0.f, 0.f, 0.f};
    bf16x8 At[4][2], B0[2][2], B1[2][2];
    const char* cA = (const char*)g.A + (size_t)cur.pm * tstep + cur.kb; const char* cB = (const char*)g.Bt + (size_t)cur.pn * tstep + cur.kb;
    S.a_ready(cur);
    if constexpr (SP2) {
        PG8_STAGE(PG8_SB(0, 0), cB, voffB); PG8_STAGE(PG8_SB(0, 1), cB + hstep, voffB); PG8_STAGE(PG8_SA(0, 0), cA, voffA); PG8_STAGE(PG8_SA(0, 1), cA + hstep, voffA);
        if (wr == 1) PG8_BAR;
        PG8_WAIT_V(2); PG8_BAR;
        PG8_STAGE(PG8_SB(1, 0), cB + kstep, voffB); PG8_STAGE(PG8_SA(1, 0), cA + kstep, voffA); PG8_STAGE(PG8_SB(1, 1), cB + hstep + kstep, voffB);
        PG8_WAIT_V(6); PG8_BAR;
    } else {
        PG8_STAGE(PG8_SB(0, 0), cB, voffB); PG8_STAGE(PG8_SA(0, 0), cA, voffA); PG8_STAGE(PG8_SB(0, 1), cB + hstep, voffB); PG8_STAGE(PG8_SA(0, 1), cA + hstep, voffA);
        if (wr == 1) PG8_BAR;
        PG8_WAIT_V(4); PG8_BAR;
        PG8_STAGE(PG8_SB(1, 0), cB + kstep, voffB); PG8_STAGE(PG8_SA(1, 0), cA + kstep, voffA); PG8_STAGE(PG8_SB(1, 1), cB + hstep + kstep, voffB);
        PG8_WAIT_V(6); PG8_BAR;
    }
    for (;;) {
        const bool has_next = S.next(ui + 1, nxt);
        const char* nA = has_next ? (const char*)g.A + (size_t)nxt.pm * tstep + nxt.kb : cA; const char* nB = has_next ? (const char*)g.Bt + (size_t)nxt.pn * tstep + nxt.kb : cB;
        for (int t = 0; t < nt; t += 2) {
            const bool last = (t == nt - 2);
            const char* a1 = cA + (size_t)(t + 1) * kstep;
            const char* a2 = last ? nA : cA + (size_t)(t + 2) * kstep; const char* b2 = last ? nB : cB + (size_t)(t + 2) * kstep;
            const char* a3 = a2 + kstep; const char* b3 = b2 + kstep;
            if (last && has_next) S.a_ready(nxt);
            if constexpr (SP2) {
            PG8_LDB(B0, 0, 0); PG8_LDB(B1, 0, 1); PG8_SCHED; PG8_LDA(At, 0, 0); PG8_STAGE(PG8_SA(1, 1), a1 + hstep, voffA);
            PG8_WAIT_V(8); PG8_WAIT_L(0); PG8_BAR; PG8_MMA(0, 0, At, B0); PG8_MMA(0, 1, At, B1); PG8_BAR; PG8_SCHED;
            PG8_LDA(At, 0, 1); PG8_STAGE(PG8_SB(0, 0), b2, voffB); PG8_STAGE(PG8_SB(0, 1), b2 + hstep, voffB); PG8_STAGE(PG8_SA(0, 0), a2, voffA);
            PG8_WAIT_V(8); PG8_WAIT_L(0); PG8_BAR; PG8_MMA(1, 0, At, B0); PG8_MMA(1, 1, At, B1); PG8_BAR; PG8_SCHED;
            PG8_LDB(B0, 1, 0); PG8_LDB(B1, 1, 1); PG8_SCHED; PG8_LDA(At, 1, 0); PG8_STAGE(PG8_SA(0, 1), a2 + hstep, voffA);
            PG8_WAIT_V(8); PG8_WAIT_L(0); PG8_BAR; PG8_MMA(0, 0, At, B0); PG8_MMA(0, 1, At, B1); PG8_BAR; PG8_SCHED;
            PG8_LDA(At, 1, 1); PG8_STAGE(PG8_SB(1, 0), b3, voffB); PG8_STAGE(PG8_SB(1, 1), b3 + hstep, voffB); PG8_STAGE(PG8_SA(1, 0), a3, voffA);
            PG8_WAIT_V(8); PG8_WAIT_L(0); PG8_BAR; PG8_MMA(1, 0, At, B0); PG8_MMA(1, 1, At, B1); PG8_BAR; PG8_SCHED;
            } else {
            PG8_LDB(B0, 0, 0); PG8_SCHED; PG8_LDA(At, 0, 0); PG8_STAGE(PG8_SA(1, 1), a1 + hstep, voffA);
            PG8_WAIT_L(8); PG8_BAR; PG8_WAIT_L(0); PG8_MMA(0, 0, At, B0); PG8_BAR; PG8_SCHED;
            PG8_LDB(B1, 0, 1); PG8_STAGE(PG8_SB(0, 0), b2, voffB);
            PG8_BAR; PG8_WAIT_L(0); PG8_MMA(0, 1, At, B1); PG8_BAR;
            PG8_LDA(At, 0, 1); PG8_STAGE(PG8_SA(0, 0), a2, voffA);
            PG8_BAR; PG8_WAIT_L(0); PG8_MMA(1, 0, At, B0); PG8_BAR; PG8_SCHED;
            PG8_STAGE(PG8_SB(0, 1), b2 + hstep, voffB);
            PG8_WAIT_V(6); PG8_BAR; PG8_MMA(1, 1, At, B1); PG8_BAR;
            PG8_LDB(B0, 1, 0); PG8_SCHED; PG8_LDA(At, 1, 0); PG8_STAGE(PG8_SA(0, 1), a2 + hstep, voffA);
            PG8_WAIT_L(8); PG8_BAR; PG8_WAIT_L(0); PG8_MMA(0, 0, At, B0); PG8_BAR; PG8_SCHED;
            PG8_LDB(B1, 1, 1); PG8_STAGE(PG8_SB(1, 0), b3, voffB);
            PG8_BAR; PG8_WAIT_L(0); PG8_MMA(0, 1, At, B1); PG8_BAR;
            PG8_LDA(At, 1, 1); PG8_STAGE(PG8_SA(1, 0), a3, voffA);
            PG8_BAR; PG8_WAIT_L(0); PG8_MMA(1, 0, At, B0); PG8_BAR; PG8_SCHED;
            PG8_STAGE(PG8_SB(1, 1), b3 + hstep, voffB);
            PG8_WAIT_V(6); PG8_BAR; PG8_MMA(1, 1, At, B1); PG8_BAR;
            }
        }
        if constexpr (ALIGN_EPI) { if (wr == 0) PG8_BAR; }
        if constexpr (!Epi::AFTER_DRAIN) { E(acc, cur, wr, wc, fr, fq); S.done(cur); }
        if (!has_next) break;
#pragma unroll
        for (int a = 0; a < 2; ++a)
#pragma unroll
            for (int b = 0; b < 2; ++b)
#pragma unroll
                for (int m = 0; m < 4; ++m)
#pragma unroll
                    for (int n = 0; n < 2; ++n) acc[a][b][m][n] = (f32x4){0.f, 0.f, 0.f, 0.f};
        cur = nxt; cA = nA; cB = nB; ++ui;
        if constexpr (ALIGN_EPI) { if (wr == 1) PG8_BAR; }
    }
    PG8_WAIT_V(0);
    if constexpr (!ALIGN_EPI) { if (wr == 0) PG8_BAR; }
    PG8_BAR;
    if constexpr (Epi::AFTER_DRAIN) { E.fused(acc, cur, wr, wc, fr, fq, lds, wid, lane); S.done(cur); }
#undef PG8_SA
#undef PG8_SB
#undef PG8_STAGE
#undef PG8_LDA
#undef PG8_LDB
#undef PG8_MMA
#undef PG8_WAIT_V
#undef PG8_WAIT_L
#undef PG8_BAR
#undef PG8_SCHED
}
}

#define LAS __attribute__((address_space(3)))
typedef unsigned short bf16;
typedef float f32x4 __attribute__((ext_vector_type(4)));
typedef short bf16x8 __attribute__((ext_vector_type(8)));
typedef short s16x4 __attribute__((ext_vector_type(4)));
typedef unsigned u32x4 __attribute__((ext_vector_type(4)));
typedef unsigned u32x2 __attribute__((ext_vector_type(2)));
constexpr int NWAVES = 8;
constexpr int DM = 1024, M_P = 16 * 2048, M_S = 16 * 64, M = M_P + M_S;
constexpr int PROJ = 11296, DI = 2048, NH = 32, NG = 8, DS = 128, CD = 4096, FF = 4096;
constexpr int N1A = 6400, N1B = 5120, NWIN = N1A + N1B;
constexpr float EPS = 1e-6f;
constexpr size_t O_Y = 0, O_CA_P = (size_t)M * DM, O_CM_P = O_CA_P + 16 * 2 * 1024, O_SS_P = O_CM_P + 16 * 3 * 4096, O_CA_S = O_SS_P + (size_t)16 * 32 * 64 * 128,
                 O_CM_S = O_CA_S + 16 * 2 * 1024, O_SS_S = O_CM_S + 16 * 3 * 4096;
constexpr size_t MiB = 1u << 20;
constexpr size_t WS_SSQ1 = 0, WS_SSQ2 = 256 * 1024, WS_BAR = 512 * 1024, WS_RX = 576 * 1024  , WS_RH = 768 * 1024  ;
constexpr size_t WS_WA = 1 * MiB;
constexpr size_t WS_WB = WS_WA + 2 * MiB;
constexpr size_t WS_WO = WS_WB + 4 * MiB;
constexpr size_t WS_W1 = WS_WO + 2 * MiB;
constexpr size_t WS_W2 = WS_W1 + 8 * MiB;
constexpr size_t WS_WINB = 25 * MiB;
constexpr size_t WS_XN = 35 * MiB;
constexpr size_t WS_DT = 101 * MiB;
constexpr size_t WS_XBC = 106 * MiB;
constexpr size_t WS_AB = 370 * MiB, WS_GA = 436 * MiB;
constexpr size_t WS_WINA = 512 * MiB - (size_t)N1A * 1024 * 2;
constexpr size_t WS_V = WS_XBC, WS_GB = WS_V + 66 * MiB, WS_MG = WS_GB + 66 * MiB, WS_MO = WS_MG + 66 * MiB;
constexpr size_t WS_F = WS_XBC, WS_F2 = WS_AB;
constexpr size_t WS_SCR = 436 * MiB;
constexpr size_t WS_VS = 502 * MiB, WS_GBS = 504 * MiB;
constexpr size_t WS_END = 512 * MiB;
static_assert(WS_W2 + 8 * MiB <= WS_WINB && WS_WINB + (size_t)N1B * 1024 * 2 <= WS_XN && WS_XN + (size_t)M * 1024 * 2 <= WS_DT && WS_DT + (size_t)M * 32 * 4 <= WS_XBC && WS_XBC + (size_t)M * 4096 * 2 <= WS_AB
              && WS_GA + (size_t)M * 1024 * 2 <= WS_END && WS_AB + (size_t)M * 1024 * 2 <= WS_WINA && WS_MO + (size_t)M * 1024 * 2 <= WS_AB, "ws map");
constexpr int LDS_BYTES = 147456;

__device__ __forceinline__ unsigned f2bf(float f) { unsigned u = __builtin_bit_cast(unsigned, f); return (u + 0x7fffu + ((u >> 16) & 1u)) >> 16; }
__device__ __forceinline__ unsigned pk2(float lo, float hi) { return pg8::cvt_pk_bf16(lo, hi); }
__device__ __forceinline__ float bflo(unsigned w) { return __uint_as_float(w << 16); }
__device__ __forceinline__ float bfhi(unsigned w) { return __uint_as_float(w & 0xffff0000u); }
__device__ __forceinline__ float bf1(bf16 b) { return __uint_as_float((unsigned)b << 16); }
__device__ __forceinline__ float wave_sum(float v) {
#pragma unroll
    for (int o = 1; o < 64; o <<= 1) v += __shfl_xor(v, o);
    return v;
}
#define LDS_WAIT() asm volatile("s_waitcnt lgkmcnt(0)" ::: "memory")

struct Args {
    const float *x_p, *x_s, *st_ca, *st_cm, *st_ss, *n_mix_pre, *w_in, *b_gate, *conv_a_w, *w_a_out, *conv_m_w, *conv_m_b, *dt_bias, *a_log, *d_skip, *ssm_norm, *w_ssm_out, *w_o,
        *n_mix_post, *n_ffn_pre, *w_ff1, *w_ff2, *n_ffn_post;
    float* out; unsigned char* ws;
    int coop_sync; int pad;
};

__device__ __forceinline__ void p0_transpose_item(const float* W, int Nsrc, int n0, int k0, bf16* WT, int Kld, int drow, LAS float* scr, int lane, const float* kscale) {
    if (n0 >= 0) {
        float tv[32];
#pragma unroll
        for (int i = 0; i < 32; ++i) { const int kk = 2 * i + (lane >> 5); tv[i] = W[(size_t)(k0 + kk) * Nsrc + n0 + (lane & 31)]; }
#pragma unroll
        for (int i = 0; i < 32; ++i) { const int kk = 2 * i + (lane >> 5); float v = tv[i]; if (kscale) v *= kscale[k0 + kk]; scr[kk * 33 + (lane & 31)] = v; }
    } else {
#pragma unroll 8
        for (int i = 0; i < 32; ++i) { const int kk = 2 * i + (lane >> 5); scr[kk * 33 + (lane & 31)] = 0.f; }
    }
    LDS_WAIT(); asm volatile("" ::: "memory");
    const int c = lane & 7;
#pragma unroll
    for (int j = 0; j < 4; ++j) { const int n = (lane >> 3) + 8 * j; const LAS float* s = scr + (8 * c) * 33 + n;
        u32x4 o; o.x = pk2(s[0 * 33], s[1 * 33]); o.y = pk2(s[2 * 33], s[3 * 33]); o.z = pk2(s[4 * 33], s[5 * 33]); o.w = pk2(s[6 * 33], s[7 * 33]);
        *(u32x4*)(WT + (size_t)(drow + n) * Kld + k0 + 8 * c) = o; }
    LDS_WAIT(); asm volatile("" ::: "memory");
}
__device__ __forceinline__ int win_src_col(int r) {
    if (r < 2048) return 3072 + r;
    if (r < 6144) return 5120 + (r - 2048);
    if (r < 6176) return 9216 + (r - 6144);
    if (r < 6400) return -1;
    if (r < 7424) return r - 6400;
    if (r < 8448) return 9248 + (r - 7424);
    if (r < 10496) { const int t = r - 8448, j = t >> 8, w = t & 255; return w < 128 ? 1024 + 128 * j + w : 2048 + 128 * j + (w - 128); }
    return 10272 + (r - 10496);
}
__device__ __forceinline__ const float* xrow_ptr(const Args& a, int m) { return m < M_P ? a.x_p + (size_t)m * DM : a.x_s + (size_t)(m - M_P) * DM; }

constexpr int CV_IN = (NWIN / 32) * 16, CV_A = 32 * 16, CV_B = 32 * 32, CV_O = 32 * 16, CV_1 = 128 * 16, CV_2 = 32 * 64;
constexpr int CV_EARLY = CV_IN + CV_A + CV_B + CV_O, CV_ALL = CV_EARLY + CV_1 + CV_2;
__device__ __forceinline__ void convert_items(const Args& a, LAS unsigned char* lds, int wave, int lane, int gw, int NGW, int lo, int hi) {
    LAS float* scr = (LAS float*)(lds + wave * 16384);
    unsigned char* ws = a.ws;
    constexpr int I_IN = CV_IN, I_A = CV_A, I_B = CV_B, I_O = CV_O, I_1 = CV_1;
    for (int it = lo + gw; it < hi; it += NGW) {
        int r = it;
        if (r < I_IN) { const int db = r >> 4, kb = r & 15; p0_transpose_item(a.w_in, PROJ, win_src_col(32 * db), 64 * kb, db < N1A / 32 ? (bf16*)(ws + WS_WINA) : (bf16*)(ws + WS_WINB) - (size_t)N1A * 1024, 1024, 32 * db, scr, lane, nullptr); continue; } r -= I_IN;
        if (r < I_A) { const int nb = r >> 4, kb = r & 15; p0_transpose_item(a.w_a_out, 1024, 32 * nb, 64 * kb, (bf16*)(ws + WS_WA), 1024, 32 * nb, scr, lane, nullptr); continue; } r -= I_A;
        if (r < I_B) { const int nb = r >> 5, kb = r & 31; p0_transpose_item(a.w_ssm_out, 1024, 32 * nb, 64 * kb, (bf16*)(ws + WS_WB), 2048, 32 * nb, scr, lane, a.ssm_norm); continue; } r -= I_B;
        if (r < I_O) { const int nb = r >> 4, kb = r & 15; p0_transpose_item(a.w_o, 1024, 32 * nb, 64 * kb, (bf16*)(ws + WS_WO), 1024, 32 * nb, scr, lane, nullptr); continue; } r -= I_O;
        if (r < I_1) { const int nb = r >> 4, kb = r & 15; p0_transpose_item(a.w_ff1, 4096, 32 * nb, 64 * kb, (bf16*)(ws + WS_W1), 1024, 32 * nb, scr, lane, a.n_ffn_pre); continue; } r -= I_1;
        { const int nb = r >> 6, kb = r & 63; p0_transpose_item(a.w_ff2, 1024, 32 * nb, 64 * kb, (bf16*)(ws + WS_W2), 4096, 32 * nb, scr, lane, nullptr); }
    }
}
__device__ __forceinline__ void p0_prologue(const Args& a, LAS unsigned char* lds, int wave, int lane) {
    const int gw = blockIdx.x * NWAVES + wave, NGW = gridDim.x * NWAVES;
    unsigned char* ws = a.ws;
    convert_items(a, lds, wave, lane, gw, NGW, 0, CV_EARLY);
    f32x4 wv[2][2];
#pragma unroll
    for (int j = 0; j < 2; ++j) { wv[j][0] = *(const f32x4*)(a.n_mix_pre + 8 * lane + 512 * j); wv[j][1] = *(const f32x4*)(a.n_mix_pre + 8 * lane + 512 * j + 4); }
    bf16* XN = (bf16*)(ws + WS_XN);
    for (int m0 = gw; m0 < M; m0 += 2 * NGW) {
        const int mm[2] = {m0, m0 + NGW < M ? m0 + NGW : m0};
        f32x4 v[2][2][2];
#pragma unroll
        for (int rr = 0; rr < 2; ++rr) { const float* xr = xrow_ptr(a, mm[rr]);
#pragma unroll
            for (int j = 0; j < 2; ++j)
#pragma unroll
                for (int e = 0; e < 2; ++e) v[rr][j][e] = __builtin_nontemporal_load((const f32x4*)(xr + 8 * lane + 512 * j + 4 * e)); }
#pragma unroll
        for (int rr = 0; rr < 2; ++rr) { float s = 0.f;
#pragma unroll
            for (int j = 0; j < 2; ++j)
#pragma unroll
                for (int e = 0; e < 2; ++e) s += (v[rr][j][e][0] * v[rr][j][e][0] + v[rr][j][e][1] * v[rr][j][e][1]) + (v[rr][j][e][2] * v[rr][j][e][2] + v[rr][j][e][3] * v[rr][j][e][3]);
            const float rstd = rsqrtf(wave_sum(s) * (1.f / DM) + EPS);
            if (lane == 0) ((float*)(ws + WS_RX))[mm[rr]] = rstd;
#pragma unroll
            for (int j = 0; j < 2; ++j) *(u32x4*)(XN + (size_t)mm[rr] * DM + 8 * lane + 512 * j) = pg8::pack8(v[rr][j][0] * rstd * wv[j][0], v[rr][j][1] * rstd * wv[j][1]); }
    }
    float* ssq1 = (float*)(ws + WS_SSQ1); float* ssq2 = (float*)(ws + WS_SSQ2);
    for (int i = blockIdx.x * 512 + threadIdx.x; i < M; i += gridDim.x * 512) { ssq1[i] = 0.f; ssq2[i] = 0.f; }
}

namespace ssd {
constexpr int CN_OFF = 0, BN_OFF = 17408, BT_OFF = 34816, XT_OFF = 53248, CB_OFF = 90112, DT_OFF = 107520, AC_OFF = 108544, SQ_OFF = 109568, ZS_OFF = 111616;
constexpr int CN_LD = 136, BT_LD = 72, XT_LD = 72, CB_LD = 68, ZS_LD = 264;
static_assert(ZS_OFF + 64 * ZS_LD * 2 <= LDS_BYTES, "ssd lds");
constexpr int PFT = 14;
#define SSD_BAR() asm volatile("s_waitcnt lgkmcnt(0)\n\ts_barrier" ::: "memory")
#define MFMA16(a, b, c) __builtin_amdgcn_mfma_f32_16x16x32_bf16((a), (b), (c), 0, 0, 0)
__device__ __forceinline__ float silu(float v) { return v * __builtin_amdgcn_rcpf(1.f + __expf(-v)); }
typedef float f32x2 __attribute__((ext_vector_type(2)));
__device__ __forceinline__ f32x2 silu2(f32x2 v) {
    f32x2 e = v * (-1.4426950408889634f); e.x = __builtin_amdgcn_exp2f(e.x); e.y = __builtin_amdgcn_exp2f(e.y); e = e + 1.0f;
    f32x2 r; r.x = __builtin_amdgcn_rcpf(e.x); r.y = __builtin_amdgcn_rcpf(e.y); return v * r;
}
__device__ __forceinline__ bf16x8 pk8(const float* v) { u32x4 w; w.x = pk2(v[0], v[1]); w.y = pk2(v[2], v[3]); w.z = pk2(v[4], v[5]); w.w = pk2(v[6], v[7]); return __builtin_bit_cast(bf16x8, w); }

__device__ __forceinline__ void unit(const Args& a, LAS unsigned char* lds, int sq, int g) {
    int tid = threadIdx.x; asm volatile("" : "+v"(tid));
    const int wid = __builtin_amdgcn_readfirstlane(tid >> 6), lane = tid & 63, r = lane & 15, q = lane >> 4;
    const int j = wid >> 1, hw = wid & 1;
    const bool samp = sq >= 16; const int sb = samp ? sq - 16 : sq;
    const int row0 = samp ? M_P + 64 * sb : 2048 * sq, nch = samp ? 1 : 32;
    const int h = 4 * g + j;
    const bf16* XBC = (const bf16*)(a.ws + WS_XBC); bf16* ZY = (bf16*)a.out; const float* DT = (const float*)(a.ws + WS_DT);
    float* o_cm = a.out + (samp ? O_CM_S : O_CM_P); float* o_ss = a.out + (samp ? O_SS_S : O_SS_P);
    LAS bf16* Cn = (LAS bf16*)(lds + CN_OFF); LAS bf16* Bn = (LAS bf16*)(lds + BN_OFF); LAS bf16* Bt = (LAS bf16*)(lds + BT_OFF); LAS bf16* Xt = (LAS bf16*)(lds + XT_OFF);
    LAS float* CB = (LAS float*)(lds + CB_OFF); LAS float* DTV = (LAS float*)(lds + DT_OFF); LAS float* AC = (LAS float*)(lds + AC_OFF); LAS float* SQ = (LAS float*)(lds + SQ_OFF);
    LAS bf16* ZS = (LAS bf16*)(lds + ZS_OFF);
    const float dsk = a.d_skip[h];

    f32x4 st[8][2];
#pragma unroll
    for (int nt = 0; nt < 8; ++nt)
#pragma unroll
        for (int pt = 0; pt < 2; ++pt) {
            if (samp) st[nt][pt] = *(const f32x4*)(a.st_ss + ((size_t)(sb * 32 + h) * 64 + 32 * hw + 16 * pt + r) * 128 + 16 * nt + 4 * q);
            else st[nt][pt] = (f32x4){0.f, 0.f, 0.f, 0.f};
        }
    const int cp = tid & 255, tb = tid >> 8, c0 = 2 * cp;
    const int col = c0 < 256 ? 256 * g + c0 : (c0 < 384 ? 2048 + 128 * g + (c0 - 256) : 3072 + 128 * g + (c0 - 384));
    float cw[4][2], cbias[2];
#pragma unroll
    for (int i = 0; i < 4; ++i) { cw[i][0] = a.conv_m_w[i * 4096 + col]; cw[i][1] = a.conv_m_w[i * 4096 + col + 1]; }
    cbias[0] = a.conv_m_b[col]; cbias[1] = a.conv_m_b[col + 1];
    const int zr = tid >> 3, zc = tid & 7;
    const int hh = 4 * g + (wid & 3);
    const float dtb = a.dt_bias[hh], aneg = -__expf(a.a_log[hh]);

    unsigned xw[3 + PFT]; float dtr = 0.f;
#define SSD_PREFETCH(cc) do { const int rowp_ = row0 + 64 * (cc); const bf16* src_ = XBC + (size_t)(rowp_ + 32 * tb) * 4096 + col; const int hv_ = (tb == 1 || (cc) > 0) ? 4096 : 0; \
        _Pragma("unroll") for (int k_ = 0; k_ < 3; ++k_) xw[k_] = *(const unsigned*)(src_ - (3 - k_) * hv_); \
        _Pragma("unroll") for (int t_ = 0; t_ < PFT; ++t_) xw[3 + t_] = *(const unsigned*)(src_ + (size_t)t_ * 4096); \
        dtr = DT[(size_t)(rowp_ + lane) * 32 + hh]; } while (0)
    SSD_PREFETCH(0);

    for (int c = 0; c < nch; ++c) {
        const int rowc = row0 + 64 * c;
        unsigned xl[32 - PFT];
        { const bf16* src = XBC + (size_t)(rowc + 32 * tb) * 4096 + col;
#pragma unroll
          for (int t = PFT; t < 32; ++t) xl[t - PFT] = *(const unsigned*)(src + (size_t)t * 4096); }
        if (wid < 4) {
            const float v = dtr + dtb;
            const float dt = v > 20.f ? v : log1pf(__expf(v));
            float ad = dt * aneg;
#pragma unroll
            for (int o = 1; o < 64; o <<= 1) { const float t = __shfl_up(ad, o); if (lane >= o) ad += t; }
            DTV[wid * 64 + lane] = dt; AC[wid * 64 + lane] = ad;
        }
        {
            f32x2 p3, p2, p1;
            const f32x2 cw0 = (f32x2){cw[0][0], cw[0][1]}, cw1 = (f32x2){cw[1][0], cw[1][1]}, cw2 = (f32x2){cw[2][0], cw[2][1]}, cw3 = (f32x2){cw[3][0], cw[3][1]}, cbv = (f32x2){cbias[0], cbias[1]};
            if (tb == 1 || c > 0) { p3 = (f32x2){bflo(xw[0]), bfhi(xw[0])}; p2 = (f32x2){bflo(xw[1]), bfhi(xw[1])}; p1 = (f32x2){bflo(xw[2]), bfhi(xw[2])}; }
            else if (samp) {
                const float* hs = a.st_cm + (size_t)sb * 3 * 4096 + col;
                p3 = (f32x2){hs[0], hs[1]}; p2 = (f32x2){hs[4096], hs[4097]}; p1 = (f32x2){hs[8192], hs[8193]};
            } else { p3 = p2 = p1 = (f32x2){0.f, 0.f}; }
            if (tb == 1 && c == nch - 1) {
#pragma unroll
                for (int k = 0; k < 3; ++k) { float* d = o_cm + (size_t)(sb * 3 + k) * 4096 + col; d[0] = bflo(xl[29 + k - PFT]); d[1] = bfhi(xl[29 + k - PFT]); }
            }
#pragma unroll
            for (int o = 0; o < 4; ++o) {
                float o0[8], o1[8];
#pragma unroll
                for (int t = 0; t < 8; ++t) {
                    const unsigned wv = (8 * o + t < PFT) ? xw[3 + ((8 * o + t) < PFT ? (8 * o + t) : 0)] : xl[(8 * o + t) >= PFT ? (8 * o + t - PFT) : 0];
                    const f32x2 xv2 = (f32x2){bflo(wv), bfhi(wv)};
                    const f32x2 ov = silu2(cw0 * p3 + (cw1 * p2 + (cw2 * p1 + (cw3 * xv2 + cbv))));
                    o0[t] = ov.x; o1[t] = ov.y;
                    p3 = p2; p2 = p1; p1 = xv2;
                }
                const int s0 = 32 * tb + 8 * o;
                if (c0 < 256) {
                    *(LAS bf16x8*)(Xt + c0 * XT_LD + s0) = pk8(o0); *(LAS bf16x8*)(Xt + (c0 + 1) * XT_LD + s0) = pk8(o1);
                } else if (c0 < 384) {
                    const int n = c0 - 256;
                    *(LAS bf16x8*)(Bt + n * BT_LD + s0) = pk8(o0); *(LAS bf16x8*)(Bt + (n + 1) * BT_LD + s0) = pk8(o1);
#pragma unroll
                    for (int t = 0; t < 8; ++t) *(LAS unsigned*)(Bn + (s0 + t) * CN_LD + n) = pk2(o0[t], o1[t]);
                } else {
                    const int n = c0 - 384;
#pragma unroll
                    for (int t = 0; t < 8; ++t) *(LAS unsigned*)(Cn + (s0 + t) * CN_LD + n) = pk2(o0[t], o1[t]);
                }
            }
        }
        u32x4 zq[4];
#pragma unroll
        for (int k = 0; k < 4; ++k) zq[k] = *(const u32x4*)(ZY + (size_t)(rowc + zr) * 2048 + 256 * g + 8 * (zc + 8 * k));
        SSD_BAR();
        SSD_PREFETCH(c + 1 < nch ? c + 1 : c);
        __builtin_amdgcn_sched_barrier(0);
        {
            const int lt = wid >> 1, st2 = (wid & 1) * 2;
            f32x4 cb0 = (f32x4){0.f, 0.f, 0.f, 0.f}, cb1 = cb0;
#pragma unroll
            for (int kk = 0; kk < 4; ++kk) {
                const bf16x8 av = *(const LAS bf16x8*)(Cn + (16 * lt + r) * CN_LD + 32 * kk + 8 * q);
                const bf16x8 b0 = *(const LAS bf16x8*)(Bn + (16 * st2 + r) * CN_LD + 32 * kk + 8 * q);
                const bf16x8 b1 = *(const LAS bf16x8*)(Bn + (16 * (st2 + 1) + r) * CN_LD + 32 * kk + 8 * q);
                cb0 = MFMA16(av, b0, cb0); cb1 = MFMA16(av, b1, cb1);
            }
#pragma unroll
            for (int i = 0; i < 4; ++i) { CB[(16 * lt + 4 * q + i) * CB_LD + 16 * st2 + r] = cb0[i]; CB[(16 * lt + 4 * q + i) * CB_LD + 16 * (st2 + 1) + r] = cb1[i]; }
        }
        f32x4 y[4][2];
#pragma unroll
        for (int lt = 0; lt < 4; ++lt) { y[lt][0] = (f32x4){0.f, 0.f, 0.f, 0.f}; y[lt][1] = y[lt][0]; }
#pragma unroll
        for (int kk = 0; kk < 4; ++kk) {
            bf16x8 hf[2];
#pragma unroll
            for (int pt = 0; pt < 2; ++pt) { float t8[8];
#pragma unroll
                for (int i = 0; i < 4; ++i) { t8[i] = st[2 * kk][pt][i]; t8[4 + i] = st[2 * kk + 1][pt][i]; }
                hf[pt] = pk8(t8); }
#pragma unroll
            for (int lt = 0; lt < 4; ++lt) {
                const s16x4 lo = *(const LAS s16x4*)(Cn + (16 * lt + r) * CN_LD + 32 * kk + 4 * q);
                const s16x4 hi = *(const LAS s16x4*)(Cn + (16 * lt + r) * CN_LD + 32 * kk + 16 + 4 * q);
                const bf16x8 av = __builtin_shufflevector(lo, hi, 0, 1, 2, 3, 4, 5, 6, 7);
                y[lt][0] = MFMA16(av, hf[0], y[lt][0]); y[lt][1] = MFMA16(av, hf[1], y[lt][1]);
            }
        }
#pragma unroll
        for (int lt = 0; lt < 4; ++lt) { const f32x4 ac = *(const LAS f32x4*)(AC + j * 64 + 16 * lt + 4 * q);
#pragma unroll
            for (int i = 0; i < 4; ++i) { const float e = __expf(ac[i]); y[lt][0][i] *= e; y[lt][1][i] *= e; } }
#pragma unroll
        for (int k = 0; k < 4; ++k) *(LAS u32x4*)(ZS + zr * ZS_LD + 8 * (zc + 8 * k)) = zq[k];
        SSD_BAR();
        {
            const float aend = AC[j * 64 + 63]; const float cdec = __expf(aend);
#pragma unroll
            for (int nt = 0; nt < 8; ++nt) { st[nt][0] *= cdec; st[nt][1] *= cdec; }
#pragma unroll
            for (int kk = 0; kk < 2; ++kk) {
                const f32x4 a0 = *(const LAS f32x4*)(AC + j * 64 + 32 * kk + 8 * q), a1 = *(const LAS f32x4*)(AC + j * 64 + 32 * kk + 8 * q + 4);
                const f32x4 d0 = *(const LAS f32x4*)(DTV + j * 64 + 32 * kk + 8 * q), d1 = *(const LAS f32x4*)(DTV + j * 64 + 32 * kk + 8 * q + 4);
                float acs[8], dts[8];
#pragma unroll
                for (int i = 0; i < 4; ++i) { acs[i] = a0[i]; acs[4 + i] = a1[i]; dts[i] = d0[i]; dts[4 + i] = d1[i]; }
                bf16x8 xf[2];
#pragma unroll
                for (int pt = 0; pt < 2; ++pt) xf[pt] = *(const LAS bf16x8*)(Xt + (j * 64 + 32 * hw + 16 * pt + r) * XT_LD + 32 * kk + 8 * q);
#pragma unroll
                for (int lt = 0; lt < 4; ++lt) {
                    if (kk == 1 && lt < 2) continue;
                    const int l = 16 * lt + r; const float al = AC[j * 64 + l];
                    const f32x4 c0v = *(const LAS f32x4*)(CB + l * CB_LD + 32 * kk + 8 * q), c1v = *(const LAS f32x4*)(CB + l * CB_LD + 32 * kk + 8 * q + 4);
                    float gv[8];
#pragma unroll
                    for (int i = 0; i < 8; ++i) { const int s = 32 * kk + 8 * q + i; const float cbv = i < 4 ? c0v[i & 3] : c1v[i & 3];
                        const float gq = cbv * __expf(al - acs[i]) * dts[i];
                        gv[i] = (kk == 0 && lt >= 2) ? gq : (s <= l ? gq : 0.f); }
                    const bf16x8 gf = pk8(gv);
                    y[lt][0] = MFMA16(gf, xf[0], y[lt][0]); y[lt][1] = MFMA16(gf, xf[1], y[lt][1]);
                }
                bf16x8 xs[2];
                float wsc[8];
#pragma unroll
                for (int i = 0; i < 8; ++i) wsc[i] = dts[i] * __expf(aend - acs[i]);
#pragma unroll
                for (int pt = 0; pt < 2; ++pt) { const u32x4 xu = __builtin_bit_cast(u32x4, xf[pt]); float t8[8];
                    t8[0] = bflo(xu.x) * wsc[0]; t8[1] = bfhi(xu.x) * wsc[1]; t8[2] = bflo(xu.y) * wsc[2]; t8[3] = bfhi(xu.y) * wsc[3];
                    t8[4] = bflo(xu.z) * wsc[4]; t8[5] = bfhi(xu.z) * wsc[5]; t8[6] = bflo(xu.w) * wsc[6]; t8[7] = bfhi(xu.w) * wsc[7];
                    xs[pt] = pk8(t8); }
#pragma unroll
                for (int nt = 0; nt < 8; ++nt) { const bf16x8 bf = *(const LAS bf16x8*)(Bt + (16 * nt + r) * BT_LD + 32 * kk + 8 * q);
                    st[nt][0] = MFMA16(bf, xs[0], st[nt][0]); st[nt][1] = MFMA16(bf, xs[1], st[nt][1]); }
            }
        }
        {
            float sq[4][4];
#pragma unroll
            for (int lt = 0; lt < 4; ++lt) {
#pragma unroll
                for (int i = 0; i < 4; ++i) sq[lt][i] = 0.f;
#pragma unroll
                for (int pt = 0; pt < 2; ++pt) {
                    const u32x2 xv = *(const LAS u32x2*)(Xt + (j * 64 + 32 * hw + 16 * pt + r) * XT_LD + 16 * lt + 4 * q);
                    const float xs4[4] = {bflo(xv.x), bfhi(xv.x), bflo(xv.y), bfhi(xv.y)};
#pragma unroll
                    for (int i = 0; i < 4; i += 2) {
                        LAS bf16* zp0 = ZS + (16 * lt + 4 * q + i) * ZS_LD + 64 * j + 32 * hw + 16 * pt + r; LAS bf16* zp1 = zp0 + ZS_LD;
                        const f32x2 zz = (f32x2){bf1(*zp0), bf1(*zp1)};
                        const f32x2 v = ((f32x2){y[lt][pt][i], y[lt][pt][i + 1]} + dsk * (f32x2){xs4[i], xs4[i + 1]}) * silu2(zz);
                        const unsigned vb = pk2(v.x, v.y); *zp0 = (bf16)(vb & 0xffffu); *zp1 = (bf16)(vb >> 16);
                        const f32x2 vr = (f32x2){bflo(vb), bfhi(vb)}; sq[lt][i] += vr.x * vr.x; sq[lt][i + 1] += vr.y * vr.y;
                    }
                }
#pragma unroll
                for (int i = 0; i < 4; ++i) { float s = sq[lt][i]; s += __shfl_xor(s, 1); s += __shfl_xor(s, 2); s += __shfl_xor(s, 4); s += __shfl_xor(s, 8); sq[lt][i] = s; }
                if (r == 0) *(LAS f32x4*)(SQ + wid * 64 + 16 * lt + 4 * q) = (f32x4){sq[lt][0], sq[lt][1], sq[lt][2], sq[lt][3]};
            }
            SSD_BAR();
            float tot = 0.f;
#pragma unroll
            for (int w = 0; w < 8; ++w) tot += SQ[w * 64 + zr];
            const float rs = rsqrtf(tot * (1.f / 256.f) + EPS);
#pragma unroll
            for (int k = 0; k < 4; ++k) { f32x4 v0, v1; pg8::unpack8(*(const LAS u32x4*)(ZS + zr * ZS_LD + 8 * (zc + 8 * k)), v0, v1);
                *(u32x4*)(ZY + (size_t)(rowc + zr) * 2048 + 256 * g + 8 * (zc + 8 * k)) = pg8::pack8(v0 * rs, v1 * rs); }
        }
    }
#undef SSD_PREFETCH
#pragma unroll
    for (int nt = 0; nt < 8; ++nt)
#pragma unroll
        for (int pt = 0; pt < 2; ++pt) *(f32x4*)(o_ss + ((size_t)(sb * 32 + h) * 64 + 32 * hw + 16 * pt + r) * 128 + 16 * nt + 4 * q) = st[nt][pt];
}
}

__device__ __forceinline__ void mixa_phase(const Args& a, int wave, int lane, int bxo, int nb) {
    const int gw = bxo * NWAVES + wave, NGW = nb * NWAVES;
    bf16* AB = (bf16*)(a.ws + WS_AB);
    for (int it0 = gw; it0 < 1056; it0 += NGW) {
        const int it = it0 >> 1, ch = 512 * (it0 & 1) + 8 * lane;
        f32x4 w0[2], w1[2], w2[2];
#pragma unroll
        for (int e = 0; e < 2; ++e) { w0[e] = *(const f32x4*)(a.conv_a_w + ch + 4 * e); w1[e] = *(const f32x4*)(a.conv_a_w + 1024 + ch + 4 * e); w2[e] = *(const f32x4*)(a.conv_a_w + 2048 + ch + 4 * e); }
        const bool samp = it >= 512; const int sb = samp ? it - 512 : it >> 5, c = samp ? 0 : it & 31, nch = samp ? 1 : 32;
        const int row = samp ? M_P + 64 * sb : 2048 * sb + 64 * c;
        const bf16* V = samp ? (const bf16*)(a.ws + WS_VS) - (size_t)M_P * 1024 : (const bf16*)(a.ws + WS_V);
        f32x4 p2[2], p1[2];
        if (c > 0) { pg8::unpack8(*(const u32x4*)(V + (size_t)(row - 2) * 1024 + ch), p2[0], p2[1]); pg8::unpack8(*(const u32x4*)(V + (size_t)(row - 1) * 1024 + ch), p1[0], p1[1]); }
        else if (samp) { const float* hs = a.st_ca + (size_t)sb * 2 * 1024 + ch; p2[0] = *(const f32x4*)hs; p2[1] = *(const f32x4*)(hs + 4); p1[0] = *(const f32x4*)(hs + 1024); p1[1] = *(const f32x4*)(hs + 1028); }
        else { p2[0] = p2[1] = p1[0] = p1[1] = (f32x4){0.f, 0.f, 0.f, 0.f}; }
        float* o_ca = a.out + (samp ? O_CA_S : O_CA_P) + (size_t)sb * 2 * 1024 + ch;
        for (int t0 = 0; t0 < 64; t0 += 8) {
            u32x4 vv[8], aa[8];
#pragma unroll
            for (int k = 0; k < 8; ++k) { vv[k] = *(const u32x4*)(V + (size_t)(row + t0 + k) * 1024 + ch); aa[k] = *(const u32x4*)(AB + (size_t)(row + t0 + k) * 1024 + ch); }
#pragma unroll
            for (int k = 0; k < 8; ++k) { const int t = t0 + k;
                f32x4 v[2], ab[2];
                pg8::unpack8(vv[k], v[0], v[1]); pg8::unpack8(aa[k], ab[0], ab[1]);
                const f32x4 u0 = ab[0] * (w0[0] * p2[0] + w1[0] * p1[0] + w2[0] * v[0]), u1 = ab[1] * (w0[1] * p2[1] + w1[1] * p1[1] + w2[1] * v[1]);
                *(u32x4*)(AB + (size_t)(row + t) * 1024 + ch) = pg8::pack8(u0, u1);
                if (c == nch - 1 && t >= 62) { *(f32x4*)(o_ca + (t - 62) * 1024) = v[0]; *(f32x4*)(o_ca + (t - 62) * 1024 + 4) = v[1]; }
                p2[0] = p1[0]; p2[1] = p1[1]; p1[0] = v[0]; p1[1] = v[1]; }
        }
    }
}

template <bool FIRST> __device__ __forceinline__ void row_phase(const Args& a, const bf16* Y, const float* SCR, int nsl, const float* SSQ, const float* wpost, bf16* HX, const float* RX, float* RH, int wave, int lane) {
    const int gw = blockIdx.x * NWAVES + wave, NGW = gridDim.x * NWAVES;
    f32x4 wp[2][2], wq[2][2];
#pragma unroll
    for (int j = 0; j < 2; ++j)
#pragma unroll
        for (int e = 0; e < 2; ++e) { wp[j][e] = *(const f32x4*)(wpost + 8 * lane + 512 * j + 4 * e); if (FIRST) { const f32x4 w = *(const f32x4*)(a.n_mix_pre + 8 * lane + 512 * j + 4 * e); wq[j][e] = (f32x4){1.f / w[0], 1.f / w[1], 1.f / w[2], 1.f / w[3]}; } }
    for (int m0 = gw; m0 < M; m0 += 2 * NGW) {
        const int mm[2] = {m0, m0 + NGW < M ? m0 + NGW : m0};
        f32x4 yq[2][2][2]; f32x4 bq[2][2][2]; float sq[2];
#pragma unroll
        for (int rr = 0; rr < 2; ++rr) { const int m = mm[rr];
            if (m < M_P) { sq[rr] = SSQ[m];
#pragma unroll
                for (int j = 0; j < 2; ++j) pg8::unpack8(*(const u32x4*)(Y + (size_t)m * DM + 8 * lane + 512 * j), yq[rr][j][0], yq[rr][j][1]);
            } else {
                const float* sr = SCR + (size_t)(m - M_P) * DM; float s = 0.f;
#pragma unroll
                for (int j = 0; j < 2; ++j)
#pragma unroll
                    for (int e = 0; e < 2; ++e) yq[rr][j][e] = (f32x4){0.f, 0.f, 0.f, 0.f};
                for (int sl = 0; sl < nsl; sl += 4) {
                    f32x4 tq[4][2][2];
#pragma unroll
                    for (int u = 0; u < 4; ++u)
#pragma unroll
                        for (int j = 0; j < 2; ++j)
#pragma unroll
                            for (int e = 0; e < 2; ++e) tq[u][j][e] = *(const f32x4*)(sr + (size_t)(sl + u) * 1024 * 1024 + 8 * lane + 512 * j + 4 * e);
#pragma unroll
                    for (int u = 0; u < 4; ++u)
#pragma unroll
                        for (int j = 0; j < 2; ++j)
#pragma unroll
                            for (int e = 0; e < 2; ++e) yq[rr][j][e] += tq[u][j][e];
                }
#pragma unroll
                for (int j = 0; j < 2; ++j)
#pragma unroll
                    for (int e = 0; e < 2; ++e) { const f32x4 t = yq[rr][j][e]; s += (t[0] * t[0] + t[1] * t[1]) + (t[2] * t[2] + t[3] * t[3]); }
                sq[rr] = wave_sum(s);
            }
#pragma unroll
            for (int j = 0; j < 2; ++j) pg8::unpack8(*(const u32x4*)(HX + (size_t)m * DM + 8 * lane + 512 * j), bq[rr][j][0], bq[rr][j][1]);
            if (FIRST) { const float rinv = 1.f / RX[m];
#pragma unroll
                for (int j = 0; j < 2; ++j) { bq[rr][j][0] = bq[rr][j][0] * rinv * wq[j][0]; bq[rr][j][1] = bq[rr][j][1] * rinv * wq[j][1]; } } }
#pragma unroll
        for (int rr = 0; rr < 2; ++rr) { const int m = mm[rr];
            const float rs = rsqrtf(sq[rr] * (1.f / DM) + EPS);
            f32x4 hv[2][2]; float s2 = 0.f;
#pragma unroll
            for (int j = 0; j < 2; ++j) {
                const f32x4 y0 = yq[rr][j][0], y1 = yq[rr][j][1];
                hv[j][0] = bq[rr][j][0] + y0 * rs * wp[j][0];
                hv[j][1] = bq[rr][j][1] + y1 * rs * wp[j][1];
#pragma unroll
                for (int e = 0; e < 2; ++e) s2 += (hv[j][e][0] * hv[j][e][0] + hv[j][e][1] * hv[j][e][1]) + (hv[j][e][2] * hv[j][e][2] + hv[j][e][3] * hv[j][e][3]);
                if (FIRST) *(u32x4*)(HX + (size_t)m * DM + 8 * lane + 512 * j) = pg8::pack8(hv[j][0], hv[j][1]);
                else { __builtin_nontemporal_store(hv[j][0], (f32x4*)(a.out + (size_t)m * DM + 8 * lane + 512 * j)); __builtin_nontemporal_store(hv[j][1], (f32x4*)(a.out + (size_t)m * DM + 8 * lane + 512 * j + 4)); }
            }
            if (FIRST) { const float rh = rsqrtf(wave_sum(s2) * (1.f / DM) + EPS); if (lane == 0) RH[m] = rh; }
        }
    }
}

#define XB_TMO      128
#define XB_XCNT(j)  (256  + 64 * (j))
#define XB_XSUB(j)  (1280 + 64 * (j))
#define XB_XGEN(j)  (2304 + 64 * (j))
#define XB_TOP      3328
#define XB_TOPGEN   3392
#define XCD_BAR_WORDS 3456
#define XB_SPIN_CAP (1u << 18)

__device__ __forceinline__ unsigned xb_ld(unsigned* p)              { return __hip_atomic_load(p, __ATOMIC_RELAXED, __HIP_MEMORY_SCOPE_AGENT); }
__device__ __forceinline__ unsigned xb_add(unsigned* p, unsigned v) { return __hip_atomic_fetch_add(p, v, __ATOMIC_RELAXED, __HIP_MEMORY_SCOPE_AGENT); }
__device__ __forceinline__ unsigned xb_xcc_id() { return (unsigned)__builtin_amdgcn_s_getreg((3 << 11) | 20) & 0xFu; }
#define XB_SPIN(cond, bar) do { unsigned _sp = 0; while (cond) { __builtin_amdgcn_s_sleep(1); \
    if ((++_sp & 255u) == 0u) { if (xb_ld(&(bar)[XB_TMO])) break; if (_sp > XB_SPIN_CAP) { atomicAdd(&(bar)[XB_TMO], 1u); break; } } } } while (0)

struct XcdBarrier {
    unsigned* bar; unsigned x;
    volatile LAS unsigned* st;
};

__device__ __forceinline__ XcdBarrier xcd_barrier_post(unsigned* bar, volatile LAS unsigned* st) {
    XcdBarrier b; b.bar = bar; b.x = xb_xcc_id(); b.st = st;
    if (threadIdx.x == 0) (void)xb_add(&bar[XB_XCNT(b.x)], 1u);
    return b;
}
__device__ __forceinline__ void xcd_barrier_complete(unsigned* bar, unsigned x, unsigned& nloc, unsigned& nx) {
    const unsigned G = gridDim.x * gridDim.y * gridDim.z;
    unsigned sum, cnt, mine, sp = 0u;
    for (;;) {
        sum = 0u; cnt = 0u; mine = 0u;
#pragma unroll
        for (unsigned j = 0; j < 16; ++j) { const unsigned c = xb_ld(&bar[XB_XCNT(j)]); sum += c; cnt += (c > 0u) ? 1u : 0u; mine = (j == x) ? c : mine; }
        if (sum == G) break;
        __builtin_amdgcn_s_sleep(1);
        if ((++sp & 255u) == 0u) { if (xb_ld(&bar[XB_TMO])) break; if (sp > XB_SPIN_CAP) { atomicAdd(&bar[XB_TMO], 1u); break; } }
    }
    nloc = mine > 0u ? mine : 1u; nx = cnt > 0u ? cnt : 1u;
}

__device__ __forceinline__ void xcd_barrier(const XcdBarrier& b) {
    asm volatile("s_waitcnt vmcnt(0)" ::: "memory");
    __syncthreads();
    if (threadIdx.x == 0) {
        unsigned* bar = b.bar;
        __builtin_amdgcn_s_waitcnt(0);
        unsigned nloc = b.st[0], nx = b.st[1];
        if (nloc == 0u) { xcd_barrier_complete(bar, b.x, nloc, nx); b.st[0] = nloc; b.st[1] = nx; }
        const unsigned old = xb_add(&bar[XB_XSUB(b.x)], 1u);
        const unsigned gen = old / nloc;
        if (old + 1u == (gen + 1u) * nloc) {
            __builtin_amdgcn_fence(__ATOMIC_RELEASE, "agent");
            asm volatile("s_waitcnt vmcnt(0)" ::: "memory");
            const unsigned og = xb_add(&bar[XB_TOP], 1u);
            const unsigned tg = og / nx;
            if (og + 1u == (tg + 1u) * nx) xb_add(&bar[XB_TOPGEN], 1u);
            else XB_SPIN(xb_ld(&bar[XB_TOPGEN]) == tg, bar);
            __builtin_amdgcn_fence(__ATOMIC_ACQUIRE, "agent");
            xb_add(&bar[XB_XGEN(b.x)], 1u);
            asm volatile("s_waitcnt vmcnt(0)" ::: "memory");
        } else {
            XB_SPIN(xb_ld(&bar[XB_XGEN(b.x)]) == gen, bar);
            __builtin_amdgcn_fence(__ATOMIC_ACQUIRE, "agent");
            asm volatile("s_waitcnt vmcnt(0)" ::: "memory");
        }
    }
    __syncthreads();
}

__global__ void __launch_bounds__(NWAVES * 64, 2) mega_fwd(Args a) {
    extern __shared__ __attribute__((aligned(16))) unsigned char lds_raw[];
    LAS unsigned char* lds = (LAS unsigned char*)lds_raw;
    cg::grid_group grid = cg::this_grid();
    int tid = threadIdx.x, lane, wave;
#define FRESH_TID() do { tid = threadIdx.x; asm volatile("" : "+v"(tid)); lane = tid & 63; wave = __builtin_amdgcn_readfirstlane(tid >> 6); } while (0)
    FRESH_TID();
    const int G = gridDim.x, bx = blockIdx.x;
    unsigned char* ws = a.ws;
    bf16* ZY = (bf16*)a.out;
    volatile LAS unsigned* bst = (volatile LAS unsigned*)(lds + LDS_BYTES - 64);
    if (tid == 0) { bst[0] = 0u; bst[1] = 0u; }
    __syncthreads();
    const XcdBarrier bar = xcd_barrier_post((unsigned*)(ws + WS_BAR), bst);
#define GRID_BAR() xcd_barrier(bar)
    if (a.coop_sync) grid.sync();
    p0_prologue(a, lds, wave, lane);
    GRID_BAR();
    { pg8::Gemm g{(const bf16*)(ws + WS_XN), (const bf16*)(ws + WS_WINA), M, N1A, 1024, 1024}; pg8::StaticOrder S; S.init(M, N1A, G, bx);
      pg8::EpiP1a E{ZY, (bf16*)(ws + WS_XBC), (float*)(ws + WS_DT)};
      pg8::gemm_phase<pg8::EpiP1a, pg8::StaticOrder, true, true>(lds, g, S, E); }
    GRID_BAR();
    { const int NS = G / 2;
      if (bx >= NS) { pg8::Gemm g{(const bf16*)(ws + WS_XN), (const bf16*)(ws + WS_WINB), M, 2048, 1024, 1024}; pg8::StaticOrder S; S.init(M, 2048, G - NS, bx - NS);
             pg8::EpiP2g E{(bf16*)(ws + WS_AB), (bf16*)(ws + WS_GA), a.b_gate};
             pg8::gemm_phase<pg8::EpiP2g, pg8::StaticOrder, true, true>(lds, g, S, E);
             const int c2 = (bx - NS) >= 32 ? (bx - NS) - 32 : (bx - NS) + (G - NS) - 32;
             pg8::Gemm g2{(const bf16*)(ws + WS_XN) + (size_t)M_P * 1024, (const bf16*)(ws + WS_WINB) + (size_t)2048 * 1024, M_S, 3072, 1024, 1024}; pg8::StaticOrder S2; S2.init(M_S, 3072, G - NS, c2);
             pg8::EpiP1b E2{(bf16*)(ws + WS_VS) - (size_t)M_P * 1024, (bf16*)(ws + WS_GBS) - (size_t)M_P * 1024, a.b_gate, 128};
             pg8::gemm_phase<pg8::EpiP1b, pg8::StaticOrder, true, true>(lds, g2, S2, E2); }
      for (int u = bx; u < 256; u += G) { ssd::unit(a, lds, u >> 3, u & 7); __syncthreads(); }
      if (G < 256) for (int u = G + bx; u < 256; u += G) { ssd::unit(a, lds, u >> 3, u & 7); __syncthreads(); } }
    GRID_BAR();
    { pg8::Gemm g{(const bf16*)(ws + WS_XN), (const bf16*)(ws + WS_WINB) + (size_t)2048 * 1024, M_P, 3072, 1024, 1024}; pg8::StaticOrder S; S.init(M_P, 3072, G, bx);
      pg8::EpiP1b E{(bf16*)(ws + WS_V), (bf16*)(ws + WS_GB), a.b_gate, 0};
      pg8::gemm_phase<pg8::EpiP1b, pg8::StaticOrder, true, true>(lds, g, S, E); }
    GRID_BAR();
    { pg8::Gemm g{(const bf16*)ZY, (const bf16*)(ws + WS_WB), M, 1024, 2048, 2048}; pg8::StaticOrder S; S.init(M, 1024, G, bx);
      pg8::EpiGate<0> E{(bf16*)(ws + WS_MG), (const bf16*)(ws + WS_GB), (const bf16*)(ws + WS_GBS) - (size_t)M_P * 1024};
      pg8::gemm_phase<pg8::EpiGate<0>, pg8::StaticOrder, true, true>(lds, g, S, E); }
    { const int ntail = (G == 256) ? 16 : 0;
      FRESH_TID(); if (bx >= ntail) mixa_phase(a, wave, lane, bx - ntail, G - ntail); }
    GRID_BAR();
    { pg8::Gemm g{(const bf16*)(ws + WS_AB), (const bf16*)(ws + WS_WA), M, 1024, 1024, 1024}; pg8::StaticOrder S; S.init(M, 1024, G, bx);
      pg8::EpiGate<1> E{(bf16*)(ws + WS_MG), (const bf16*)(ws + WS_GA), (const bf16*)(ws + WS_GA)};
      pg8::gemm_phase<pg8::EpiGate<1>, pg8::StaticOrder, true, true>(lds, g, S, E); }
    { const int ntail = (G == 256) ? 16 : 0;
      FRESH_TID(); if (bx >= ntail) convert_items(a, lds, wave, lane, (bx - ntail) * NWAVES + wave, (G - ntail) * NWAVES, CV_EARLY, CV_ALL); }
    GRID_BAR();
    { pg8::Gemm g{(const bf16*)(ws + WS_MG), (const bf16*)(ws + WS_WO), M, 1024, 1024, 1024}; pg8::StaticOrder S; S.init(M_P, 1024, G, bx);
      pg8::EpiSsq E{(bf16*)(ws + WS_MO), (float*)(ws + WS_SSQ1)};
      pg8::gemm_phase<pg8::EpiSsq, pg8::StaticOrder, true, true>(lds, g, S, E); }
    { pg8::Gemm g{(const bf16*)(ws + WS_MG), (const bf16*)(ws + WS_WO), M, 1024, 1024, 128}; pg8::TailOrder S{G, bx, 8, 128 * 2};
      pg8::EpiPartial E{(float*)(ws + WS_SCR), 128 * 2};
      pg8::gemm_phase<pg8::EpiPartial, pg8::TailOrder, true, true>(lds, g, S, E); }
    GRID_BAR();
    FRESH_TID(); row_phase<true>(a, (const bf16*)(ws + WS_MO), (const float*)(ws + WS_SCR), 8, (const float*)(ws + WS_SSQ1), a.n_mix_post, (bf16*)(ws + WS_XN), (const float*)(ws + WS_RX), (float*)(ws + WS_RH), wave, lane);
    GRID_BAR();
    { pg8::Gemm g{(const bf16*)(ws + WS_XN), (const bf16*)(ws + WS_W1), M, FF, 1024, 1024}; pg8::StaticOrder S; S.init(M, FF, G, bx);
      pg8::EpiRelu2 E{(bf16*)(ws + WS_F), (const float*)(ws + WS_RH)};
      pg8::gemm_phase<pg8::EpiRelu2, pg8::StaticOrder, true, true>(lds, g, S, E); }
    GRID_BAR();
    { pg8::Gemm g{(const bf16*)(ws + WS_F), (const bf16*)(ws + WS_W2), M, 1024, FF, FF}; pg8::StaticOrder S; S.init(M_P, 1024, G, bx);
      pg8::EpiSsq E{(bf16*)(ws + WS_F2), (float*)(ws + WS_SSQ2)};
      pg8::gemm_phase<pg8::EpiSsq, pg8::StaticOrder, true, true>(lds, g, S, E); }
    { pg8::Gemm g{(const bf16*)(ws + WS_F), (const bf16*)(ws + WS_W2), M, 1024, FF, 256}; pg8::TailOrder S{G, bx, 16, 256 * 2};
      pg8::EpiPartial E{(float*)(ws + WS_SCR), 256 * 2};
      pg8::gemm_phase<pg8::EpiPartial, pg8::TailOrder, true, true>(lds, g, S, E); }
    GRID_BAR();
    FRESH_TID(); row_phase<false>(a, (const bf16*)(ws + WS_F2), (const float*)(ws + WS_SCR), 16, (const float*)(ws + WS_SSQ2), a.n_ffn_post, (bf16*)(ws + WS_XN), nullptr, nullptr, wave, lane);
}

extern "C" void kernel_launch(void* const* d_in, const int* in_sizes, int n_in, void* d_out, int out_size, void* d_ws, size_t ws_size, hipStream_t stream) {
    static int grid = 0;
    if (grid == 0) {
        if (n_in != 23 || ws_size < WS_END) { fprintf(stderr, "kernel_launch: unexpected n_in %d / ws_size %zu (need %zu)\n", n_in, ws_size, (size_t)WS_END); grid = -1; return; }
        int dev = 0, cus = 0, per_cu = 0;
        hipGetDevice(&dev); hipDeviceGetAttribute(&cus, hipDeviceAttributeMultiprocessorCount, dev);
        if (hipFuncSetAttribute((const void*)mega_fwd, hipFuncAttributeMaxDynamicSharedMemorySize, LDS_BYTES) != hipSuccess) { fprintf(stderr, "kernel_launch: hipFuncSetAttribute failed\n"); grid = -1; return; }
        if (hipOccupancyMaxActiveBlocksPerMultiprocessor(&per_cu, (const void*)mega_fwd, NWAVES * 64, LDS_BYTES) != hipSuccess || per_cu < 1) { fprintf(stderr, "kernel_launch: occupancy query says %d\n", per_cu); per_cu = 1; }
        (void)hipGetLastError();
        grid = cus * 1;
    }
    if (grid < 0) return;
    Args a{};
    const float** f = (const float**)&a;
    for (int i = 0; i < 23; ++i) f[i] = (const float*)d_in[i];
    a.out = (float*)d_out; a.ws = (unsigned char*)d_ws;
    if (hipMemsetAsync((char*)d_ws + WS_BAR, 0, XCD_BAR_WORDS * 4, stream) != hipSuccess) { fprintf(stderr, "kernel_launch: hipMemsetAsync of the barrier words failed\n"); return; }
    void* args[] = {&a};
    hipError_t e = hipLaunchCooperativeKernel((const void*)mega_fwd, dim3(grid), dim3(NWAVES * 64), args, LDS_BYTES, stream);
    if (e != hipSuccess) fprintf(stderr, "kernel_launch: cooperative launch failed: %s (grid %d)\n", hipGetErrorString(e), grid);
}
```
